# Optimizing an MI355X kernel written in HIP

```python
import jax, jax.numpy as jnp
from jax import lax
import numpy as np

D_MODEL = 1024
BATCH = 2
SEQ = 16384
DEPTH = 4

PLE_DIM = 256
GM_HEADS = 8
GM_HEAD_DIM = 64
GM_WIDTH = GM_HEADS * GM_HEAD_DIM
GM_CHUNK = 128
ML_HEADS = 4
ML_HEAD_DIM = 128
ML_WIDTH = ML_HEADS * ML_HEAD_DIM
ML_CHUNK = 128
QK_CONV = 4
FFN_CONV = 3
D_FF = 2816
D_MIX = GM_WIDTH + ML_WIDTH
IN_COLS = 2 * GM_WIDTH + 4 * ML_WIDTH + 2 * ML_HEADS
EPS = 1e-6

kernel_name = "hymba_style_gmlp_mlstm_hybrid"


def rms_norm(x, g):
    xf = x.astype(jnp.float32)
    y = xf * lax.rsqrt(jnp.mean(xf * xf, axis=-1, keepdims=True) + EPS)
    return (y * g).astype(x.dtype)


def layer_norm(x, g, b):
    xf = x.astype(jnp.float32)
    mu = jnp.mean(xf, axis=-1, keepdims=True)
    xc = xf - mu
    y = xc * lax.rsqrt(jnp.mean(xc * xc, axis=-1, keepdims=True) + EPS)
    return (y * g + b).astype(x.dtype)


def causal_dwconv(x, w, b):
    K = w.shape[0]
    S = x.shape[1]
    xp = jnp.pad(x, ((0, 0), (K - 1, 0), (0, 0)))
    out = xp[:, 0:S] * w[0]
    for j in range(1, K):
        out = out + xp[:, j:j + S] * w[j]
    return out + b


def gmlp_mixer(u, v, ln_g, ln_b, ws, bs):
    Bn, S, _ = u.shape
    n = S // GM_CHUNK
    u = jax.nn.gelu(u, approximate=False)
    v = layer_norm(jax.nn.gelu(v, approximate=False), ln_g, ln_b)
    vc = v.reshape(Bn, n, GM_CHUNK, GM_HEADS, GM_HEAD_DIM)
    causal = jnp.tril(jnp.ones((GM_CHUNK, GM_CHUNK), dtype=bool))
    ws = jnp.where(causal[None], ws, jnp.zeros_like(ws))
    mixed = jnp.einsum('hts,bcshd->bcthd', ws, vc) + bs.T[:, :, None]
    return u * mixed.reshape(Bn, S, GM_WIDTH)


def _mlstm_state_step(carry, xs):
    C, nv, m = carry
    k_c, v_c, a_c, bL_c = xs
    m_new = jnp.maximum(bL_c + m, jnp.max(a_c, axis=-1))
    decay = jnp.exp(bL_c + m - m_new)
    w = jnp.exp(a_c - m_new[..., None])
    C_new = decay[..., None, None] * C + jnp.einsum('bhl,bhld,bhle->bhde', w, k_c, v_c)
    n_new = decay[..., None] * nv + jnp.einsum('bhl,bhld->bhd', w, k_c)
    return (C_new, n_new, m_new), (C, nv, m)


def mlstm_mixer(q, k, v, ig, fg, o, norm_g):
    Bn, S, _ = q.shape
    n = S // ML_CHUNK
    L, H, dh = ML_CHUNK, ML_HEADS, ML_HEAD_DIM
    f32 = jnp.float32

    def heads(t):
        return t.astype(f32).reshape(Bn, n, L, H, dh).transpose(0, 3, 1, 2, 4)

    def gates(t):
        return t.astype(f32).reshape(Bn, n, L, H).transpose(0, 3, 1, 2)

    qh = heads(q)
    kh = heads(k) * (dh ** -0.5)
    vh = heads(v)
    ig = gates(ig)
    lf = jax.nn.log_sigmoid(gates(fg))
    b = jnp.cumsum(lf, axis=-1)
    bL = b[..., -1]
    a = bL[..., None] - b + ig

    mv = lambda t: jnp.moveaxis(t, 2, 0)
    init = (jnp.zeros((Bn, H, dh, dh), f32), jnp.zeros((Bn, H, dh), f32), jnp.zeros((Bn, H), f32))
    _, (C0, n0, m0) = lax.scan(_mlstm_state_step, init, (mv(kh), mv(vh), mv(a), mv(bL)))
    C0 = jnp.moveaxis(C0, 0, 2)
    n0 = jnp.moveaxis(n0, 0, 2)
    m0 = jnp.moveaxis(m0, 0, 2)

    causal = jnp.tril(jnp.ones((L, L), dtype=bool))
    logD = jnp.where(causal, b[..., :, None] - b[..., None, :] + ig[..., None, :], -jnp.inf)
    inter = b + m0[..., None]
    m_t = jnp.maximum(jnp.max(logD, axis=-1), inter)
    wD = jnp.exp(logD - m_t[..., None])
    inter_w = jnp.exp(inter - m_t)
    s = jnp.einsum('bhntd,bhnsd->bhnts', qh, kh) * wD
    num = inter_w[..., None] * jnp.einsum('bhntd,bhnde->bhnte', qh, C0) + jnp.einsum('bhnts,bhnse->bhnte', s, vh)
    den = inter_w * jnp.einsum('bhntd,bhnd->bhnt', qh, n0) + jnp.sum(s, axis=-1)
    hr = num / jnp.maximum(jnp.abs(den), jnp.exp(-m_t))[..., None]
    hr = hr.transpose(0, 2, 3, 1, 4).reshape(Bn, S, H, dh)
    hc = jax.nn.sigmoid(o.astype(f32)).reshape(Bn, S, H, dh) * hr
    hn = hc * lax.rsqrt(jnp.mean(hc * hc, axis=-1, keepdims=True) + EPS) * norm_g.reshape(H, dh)
    return hn.reshape(Bn, S, ML_WIDTH).astype(v.dtype)


def setup_inputs(seed: int = 0) -> dict:
    key = jax.random.key(seed)
    ks = jax.random.split(key, 24)
    nrm = lambda k, shape, sc: jax.random.normal(k, shape, jnp.float32) * sc
    f_bias = jnp.broadcast_to(jnp.linspace(3.0, 6.0, ML_HEADS, dtype=jnp.float32), (DEPTH, ML_HEADS))
    return {
        "x": nrm(ks[0], (BATCH, SEQ, D_MODEL), 1.0),
        "p": nrm(ks[1], (DEPTH, BATCH, SEQ, PLE_DIM), 1.0),
        "g_mix": 1.0 + nrm(ks[2], (DEPTH, D_MODEL), 0.02),
        "w_in": nrm(ks[3], (DEPTH, D_MODEL, IN_COLS), D_MODEL ** -0.5),
        "gm_ln_g": 1.0 + nrm(ks[4], (DEPTH, GM_WIDTH), 0.02),
        "gm_ln_b": nrm(ks[5], (DEPTH, GM_WIDTH), 0.02),
        "gm_ws": nrm(ks[6], (DEPTH, GM_HEADS, GM_CHUNK, GM_CHUNK), GM_CHUNK ** -0.5),
        "gm_bs": 1.0 + nrm(ks[7], (DEPTH, GM_HEADS, GM_CHUNK), 0.02),
        "ml_conv_w": nrm(ks[8], (DEPTH, QK_CONV, 2 * ML_WIDTH), QK_CONV ** -0.5),
        "ml_conv_b": nrm(ks[9], (DEPTH, 2 * ML_WIDTH), 0.02),
        "ml_b_i": nrm(ks[10], (DEPTH, ML_HEADS), 0.1),
        "ml_b_f": f_bias + nrm(ks[11], (DEPTH, ML_HEADS), 0.1),
        "ml_norm_g": 1.0 + nrm(ks[12], (DEPTH, ML_WIDTH), 0.02),
        "w_out": nrm(ks[13], (DEPTH, D_MIX, D_MODEL), D_MIX ** -0.5),
        "g_ffn": 1.0 + nrm(ks[14], (DEPTH, D_MODEL), 0.02),
        "w_up": nrm(ks[15], (DEPTH, D_MODEL, 2 * D_FF), D_MODEL ** -0.5),
        "ffn_conv_w": nrm(ks[16], (DEPTH, FFN_CONV, 2 * D_FF), FFN_CONV ** -0.5),
        "ffn_conv_b": nrm(ks[17], (DEPTH, 2 * D_FF), 0.02),
        "w_down": nrm(ks[18], (DEPTH, D_FF, D_MODEL), D_FF ** -0.5),
        "g_ple": 1.0 + nrm(ks[19], (DEPTH, D_MODEL), 0.02),
        "w_ple_gate": nrm(ks[20], (DEPTH, D_MODEL, D_MODEL), D_MODEL ** -0.5),
        "w_ple": nrm(ks[21], (DEPTH, PLE_DIM, D_MODEL), PLE_DIM ** -0.5),
        "g_final": 1.0 + nrm(ks[22], (D_MODEL,), 0.02),
    }


def reference(x, p, g_mix, w_in, gm_ln_g, gm_ln_b, gm_ws, gm_bs, ml_conv_w, ml_conv_b, ml_b_i, ml_b_f, ml_norm_g, w_out, g_ffn, w_up, ffn_conv_w, ffn_conv_b, w_down, g_ple, w_ple_gate, w_ple, g_final):
    cuts = [GM_WIDTH, 2 * GM_WIDTH, 2 * GM_WIDTH + 2 * ML_WIDTH, 2 * GM_WIDTH + 3 * ML_WIDTH,
            2 * GM_WIDTH + 4 * ML_WIDTH, 2 * GM_WIDTH + 4 * ML_WIDTH + ML_HEADS]
    for i in range(DEPTH):
        h = rms_norm(x, g_mix[i])
        proj = h @ w_in[i]
        u, v, qk, vm, o, ig, fg = jnp.split(proj, cuts, axis=-1)
        gm = gmlp_mixer(u, v, gm_ln_g[i], gm_ln_b[i], gm_ws[i], gm_bs[i])
        qk = jax.nn.silu(causal_dwconv(qk, ml_conv_w[i], ml_conv_b[i]))
        q, k = jnp.split(qk, 2, axis=-1)
        ml = mlstm_mixer(q, k, vm, ig + ml_b_i[i], fg + ml_b_f[i], o, ml_norm_g[i])
        x = x + jnp.concatenate([gm, ml], axis=-1) @ w_out[i]
        h = rms_norm(x, g_ffn[i])
        up = causal_dwconv(h @ w_up[i], ffn_conv_w[i], ffn_conv_b[i])
        a, bv = jnp.split(up, 2, axis=-1)
        x = x + (jax.nn.silu(a) * bv) @ w_down[i]
        gate = jax.nn.sigmoid(rms_norm(x, g_ple[i]) @ w_ple_gate[i])
        x = x + gate * (p[i] @ w_ple[i])
    return rms_norm(x, g_final)
```

```cpp
#include <hip/hip_runtime.h>
#include <hip/hip_cooperative_groups.h>
#include <cstdio>
namespace cg = cooperative_groups;
namespace pg8 {
#define PG8_LAS __attribute__((address_space(3)))
typedef unsigned short bf16_t;
typedef short bf16x8 __attribute__((ext_vector_type(8)));
typedef float f32x4 __attribute__((ext_vector_type(4)));
typedef unsigned u32x4 __attribute__((ext_vector_type(4)));
constexpr int BM = 256, BK = 64, HALF = 128, HTB = HALF * BK * 2  , STAGE_BYTES = 8 * HTB, NXCD = 8, WGM = 8;

__host__ __device__ __forceinline__ int lds_byte(int r, int c) { const int st = (r >> 4) * 2 + (c >> 5), rr = r & 15, cc = c & 31, ob = rr * 64 + cc * 2; return st * 1024 + (ob ^ (((ob >> 9) & 1) << 5)); }
__host__ __device__ __forceinline__ void stage_rc(int b, int& R, int& C) { const int st = b / 1024, sb = b % 1024, swz = sb ^ (((sb >> 9) & 1) << 5); R = (st >> 1) * 16 + swz / 64; C = (st & 1) * 32 + (swz % 64) / 2; }
__host__ __device__ __forceinline__ int perm32(int rho) { const int n = rho >> 4, i = rho & 15; return 8 * (i >> 2) + 4 * n + (i & 3); }
__device__ __forceinline__ int otid() { int t = (int)threadIdx.x; asm volatile("" : "+v"(t)); return t; }
__device__ __forceinline__ int obid() { int t = (int)blockIdx.x; asm volatile("" : "+s"(t)); return t; }
struct Unit { int pm, pn; };
struct Gemm { const bf16_t* A; const bf16_t* Bt; int M, N, K, lda; };

struct StaticOrder {
    int nM, nN, nwg, G, c;
    __host__ __device__ void init(int M, int N, int G_, int c_) { nM = M / BM; nN = N / BM; nwg = nM * nN; G = G_; c = c_; }
    __host__ __device__ bool next(int i, Unit& u) const {
        const long L = (long)i * G + c; if (L >= nwg) return false;
        int wgid = (int)L; { const int q = nwg / NXCD, r = nwg % NXCD, xcd = wgid % NXCD, off = wgid / NXCD; wgid = (xcd < r ? xcd * (q + 1) : r * (q + 1) + (xcd - r) * q) + off; }
        const int nig = WGM * nN, gid = wgid / nig, fm = gid * WGM, gsz = (nM - fm) < WGM ? (nM - fm) : WGM;
        u.pm = fm + ((wgid % nig) % gsz); u.pn = (wgid % nig) / gsz; return true;
    }
    __device__ __forceinline__ void a_ready(const Unit&) const {}
    __device__ __forceinline__ void done(const Unit&) const {}
};
__device__ __forceinline__ unsigned cvt_pk_bf16(float lo, float hi) { typedef __bf16 bf2_t __attribute__((ext_vector_type(2))); typedef float f2_t __attribute__((ext_vector_type(2))); const bf2_t r = __builtin_convertvector((f2_t){lo, hi}, bf2_t); return __builtin_bit_cast(unsigned, r); }
typedef float f32x2 __attribute__((ext_vector_type(2)));
__device__ __forceinline__ f32x2 gelu_pk(f32x2 v) {
    const f32x2 av = __builtin_elementwise_abs(v), d = av * 0.2316418882f + 1.0f;
    f32x2 t; t.x = __builtin_amdgcn_rcpf(d.x); t.y = __builtin_amdgcn_rcpf(d.y);
    f32x2 q = t * 0.5307027145f + (-0.7265760135f); q = q * t + 0.7107068705f; q = q * t + (-0.142248368f); q = q * t + 0.127414796f; q = q * t;
    const f32x2 s = (v * v) * (-0.72134752044f);
    f32x2 e; e.x = __builtin_amdgcn_exp2f(s.x); e.y = __builtin_amdgcn_exp2f(s.y);
    const f32x2 m = v * (q * e), r = v - m;
    f32x2 o; o.x = v.x < 0.f ? m.x : r.x; o.y = v.y < 0.f ? m.y : r.y; return o;
}

template <class Epi, class Sched>
__device__ __forceinline__ void gemm_phase(PG8_LAS unsigned char* lds, const Gemm g, const Sched& S, const Epi& E) {
    const int tid = otid(), wid = __builtin_amdgcn_readfirstlane(tid >> 6), lane = tid & 63, wr = wid >> 2, wc = wid & 3, fr = lane & 15, fq = lane >> 4;
    const int K = g.K, nt = K / BK;
    unsigned voffA[2], voffB[2];
#pragma unroll
    for (int i = 0; i < 2; ++i) { int R, C; stage_rc(tid * 16 + i * 8192, R, C); const int Rb = Epi::PERM ? ((R & ~31) + perm32(R & 31)) : R;
        const int Ra = Epi::APERM ? ((R & ~63) + 4 * (R & 15) + ((R >> 4) & 3)) : R;
        voffA[i] = (unsigned)(Ra * g.lda + C) * 2u; voffB[i] = (unsigned)(Rb * K + C) * 2u; }
    const size_t kstep = (size_t)(BK * 2);
    const size_t hstepB = (size_t)HALF * K * 2, hstepA = (size_t)HALF * g.lda * 2;
    const size_t tstepB = 2 * hstepB, tstepA = 2 * hstepA;
    const unsigned ldsw = (unsigned)wid * 1024u;
    const int aoff = lds_byte(wr * 64 + fr, fq * 8), boff = lds_byte(wc * 32 + fr, fq * 8);
#define PG8_SA(b, h) (((b) * 2 + (h)) * HTB)
#define PG8_SB(b, h) ((4 + (b) * 2 + (h)) * HTB)
#define PG8_STAGE(bufoff, gbase, voff) do { _Pragma("unroll") for (int _i = 0; _i < 2; ++_i) \
        __builtin_amdgcn_global_load_lds((const unsigned*)((const char*)(gbase) + (voff)[_i]), (PG8_LAS unsigned*)(lds + (bufoff) + ldsw + _i * 8192), 16, 0, 0); } while (0)
#define PG8_LDA(dst, b, h) do { _Pragma("unroll") for (int m = 0; m < 4; ++m) _Pragma("unroll") for (int k = 0; k < 2; ++k) dst[m][k] = *(const PG8_LAS bf16x8*)(lds + PG8_SA(b, h) + aoff + m * 2048 + k * 1024); } while (0)
#define PG8_LDB(dst, b, h) do { _Pragma("unroll") for (int n = 0; n < 2; ++n) _Pragma("unroll") for (int k = 0; k < 2; ++k) dst[n][k] = *(const PG8_LAS bf16x8*)(lds + PG8_SB(b, h) + boff + n * 2048 + k * 1024); } while (0)
#define PG8_MMA(ai, bj, At, Bt) do { __builtin_amdgcn_s_setprio(1); _Pragma("unroll") for (int m = 0; m < 4; ++m) _Pragma("unroll") for (int n = 0; n < 2; ++n) _Pragma("unroll") for (int k = 0; k < 2; ++k) \
        acc[ai][bj][m][n] = __builtin_amdgcn_mfma_f32_16x16x32_bf16(Bt[n][k], At[m][k], acc[ai][bj][m][n], 0, 0, 0); __builtin_amdgcn_s_setprio(0); } while (0)
#define PG8_WAIT_V(n) asm volatile("s_waitcnt vmcnt(" #n ")" ::: "memory")
#define PG8_WAIT_L(n) asm volatile("s_waitcnt lgkmcnt(" #n ")" ::: "memory")
#define PG8_BAR __builtin_amdgcn_s_barrier()
#define PG8_SCHED __builtin_amdgcn_sched_barrier(0)
    Unit cur, nxt; int ui = 0;
    if (!S.next(0, cur)) return;
    f32x4 acc[2][2][4][2];
#pragma unroll
    for (int a = 0; a < 2; ++a)
#pragma unroll
        for (int b = 0; b < 2; ++b)
#pragma unroll
            for (int m = 0; m < 4; ++m)
#pragma unroll
                for (int n = 0; n < 2; ++n) acc[a][b][m][n] = (f32x4){0.f, 0.f, 0.f, 0.f};
    bf16x8 At[4][2], B0[2][2], B1[2][2];
    const char* cA = (const char*)g.A + (size_t)cur.pm * tstepA; const char* cB = (const char*)g.Bt + (size_t)cur.pn * tstepB;
    S.a_ready(cur);
    PG8_STAGE(PG8_SB(0, 0), cB, voffB); PG8_STAGE(PG8_SA(0, 0), cA, voffA); PG8_STAGE(PG8_SB(0, 1), cB + hstepB, voffB); PG8_STAGE(PG8_SA(0, 1), cA + hstepA, voffA);
    if (wr == 1) PG8_BAR;
    PG8_WAIT_V(4); PG8_BAR;
    PG8_STAGE(PG8_SB(1, 0), cB + kstep, voffB); PG8_STAGE(PG8_SA(1, 0), cA + kstep, voffA); PG8_STAGE(PG8_SB(1, 1), cB + hstepB + kstep, voffB);
    PG8_WAIT_V(6); PG8_BAR;
    for (;;) {
        const bool has_next = S.next(ui + 1, nxt);
        const char* nA = has_next ? (const char*)g.A + (size_t)nxt.pm * tstepA : cA; const char* nB = has_next ? (const char*)g.Bt + (size_t)nxt.pn * tstepB : cB;
        for (int t = 0; t < nt; t += 2) {
            const bool last = (t == nt - 2);
            const char* a1 = cA + (size_t)(t + 1) * kstep;
            const char* a2 = last ? nA : cA + (size_t)(t + 2) * kstep; const char* b2 = last ? nB : cB + (size_t)(t + 2) * kstep;
            const char* a3 = a2 + kstep; const char* b3 = b2 + kstep;
            if (last && has_next) S.a_ready(nxt);
            PG8_LDB(B0, 0, 0); PG8_SCHED; PG8_LDA(At, 0, 0); PG8_STAGE(PG8_SA(1, 1), a1 + hstepA, voffA);
            PG8_WAIT_L(8); PG8_BAR; PG8_WAIT_L(0); PG8_MMA(0, 0, At, B0); PG8_BAR; PG8_SCHED;
            PG8_LDB(B1, 0, 1); PG8_STAGE(PG8_SB(0, 0), b2, voffB);
            PG8_BAR; PG8_WAIT_L(0); PG8_MMA(0, 1, At, B1); PG8_BAR;
            PG8_LDA(At, 0, 1); PG8_STAGE(PG8_SA(0, 0), a2, voffA);
            PG8_BAR; PG8_WAIT_L(0); PG8_MMA(1, 0, At, B0); PG8_BAR; PG8_SCHED;
            PG8_STAGE(PG8_SB(0, 1), b2 + hstepB, voffB);
            PG8_WAIT_V(6); PG8_BAR; PG8_MMA(1, 1, At, B1); PG8_BAR;
            PG8_LDB(B0, 1, 0); PG8_SCHED; PG8_LDA(At, 1, 0); PG8_STAGE(PG8_SA(0, 1), a2 + hstepA, voffA);
            PG8_WAIT_L(8); PG8_BAR; PG8_WAIT_L(0); PG8_MMA(0, 0, At, B0); PG8_BAR; PG8_SCHED;
            PG8_LDB(B1, 1, 1); PG8_STAGE(PG8_SB(1, 0), b3, voffB);
            PG8_BAR; PG8_WAIT_L(0); PG8_MMA(0, 1, At, B1); PG8_BAR;
            PG8_LDA(At, 1, 1); PG8_STAGE(PG8_SA(1, 0), a3, voffA);
            PG8_BAR; PG8_WAIT_L(0); PG8_MMA(1, 0, At, B0); PG8_BAR; PG8_SCHED;
            PG8_STAGE(PG8_SB(1, 1), b3 + hstepB, voffB);
            PG8_WAIT_V(6); PG8_BAR; PG8_MMA(1, 1, At, B1); PG8_BAR;
        }
        if constexpr (!Epi::AFTER_DRAIN) { E(acc, cur, wr, wc, fr, fq); S.done(cur); }
        if (!has_next) break;
#pragma unroll
        for (int a = 0; a < 2; ++a)
#pragma unroll
            for (int b = 0; b < 2; ++b)
#pragma unroll
                for (int m = 0; m < 4; ++m)
#pragma unroll
                    for (int n = 0; n < 2; ++n) acc[a][b][m][n] = (f32x4){0.f, 0.f, 0.f, 0.f};
        cur = nxt; cA = nA; cB = nB; ++ui;
    }
    PG8_WAIT_V(0);
    if (wr == 0) PG8_BAR;
    PG8_BAR;
    if constexpr (Epi::AFTER_DRAIN) { E.fused(acc, cur, wr, wc, fr, fq, lds, wid, lane); S.done(cur); }
#undef PG8_SA
#undef PG8_SB
#undef PG8_STAGE
#undef PG8_LDA
#undef PG8_LDB
#undef PG8_MMA
#undef PG8_WAIT_V
#undef PG8_WAIT_L
#undef PG8_BAR
#undef PG8_SCHED
}
}

using pg8::otid; using pg8::obid; using pg8::bf16_t; using pg8::bf16x8; using pg8::f32x4; using pg8::u32x4; using pg8::f32x2; using pg8::cvt_pk_bf16; using pg8::gelu_pk;
typedef unsigned u32x2 __attribute__((ext_vector_type(2)));
typedef PG8_LAS unsigned char* ldsp;

constexpr int NTOK = 32768, SEQ = 16384, DM = 1024, DEPTH = 4, PROJ_LD = 3072, DFF = 2816, UPN = 5632;
constexpr float EPS = 1e-6f;
constexpr int LDS_BYTES = 131072 + 1024 + 8192 + 16;
constexpr size_t MiB = 1ull << 20;
constexpr size_t WS_XB0 = 0, WS_XB1 = 64 * MiB, WS_WT = 128 * MiB;
constexpr size_t WT_IN = 0, WT_OUT = 6291456, WT_UP = 8388608, WT_DOWN = 19922944, WT_GATE = 25690112, WT_PLE = 27787264, WT_WSB = 28311552, WT_LAYER = 28573696;
constexpr size_t WS_SMALL = 237 * MiB;
constexpr size_t WS_SSQ0 = WS_SMALL, WS_SSQ1 = WS_SMALL + 2 * MiB, WS_LNSTAT = WS_SMALL + 4 * MiB, WS_GATES = WS_SMALL + 6 * MiB, WS_DN = WS_SMALL + 7 * MiB;
constexpr size_t WS_CHBL = WS_SMALL + 7 * MiB + 512 * 1024, WS_CHAMAX = WS_CHBL + 4096, WS_CHM0 = WS_CHBL + 8192, WS_WG = WS_CHBL + 65536, WS_BAR = WS_CHBL + 65536 + 131072;
constexpr size_t WS_R = 245 * MiB;
constexpr size_t WS_PROJ = WS_R, WS_DC = WS_R + 192 * MiB, WS_ACT = WS_R, WS_HALO = WS_R + 176 * MiB, WS_PBF = WS_R + 176 * MiB, WS_PE = WS_R;
constexpr size_t WS_END = WS_R + 264 * MiB;

struct Params { const float* in[23]; float* out; unsigned char* ws; };
typedef const Params __attribute__((address_space(4)))* KP;
__device__ __forceinline__ KP okp(KP p) { asm volatile("" : "+s"(p)); return p; }

__device__ __forceinline__ float bflo(unsigned w) { return __uint_as_float(w << 16); }
__device__ __forceinline__ float bfhi(unsigned w) { return __uint_as_float(w & 0xffff0000u); }
__device__ __forceinline__ bf16_t f2bf(float f) { return (bf16_t)(cvt_pk_bf16(f, 0.f) & 0xffffu); }
__device__ __forceinline__ float bf2f(bf16_t b) { return __uint_as_float(((unsigned)b) << 16); }
__device__ __forceinline__ float sigmoid_f(float x) { return __builtin_amdgcn_rcpf(1.f + __builtin_amdgcn_exp2f(x * -1.4426950408889634f)); }
__device__ __forceinline__ float silu_f(float x) { return x * __builtin_amdgcn_rcpf(1.f + __builtin_amdgcn_exp2f(x * -1.4426950408889634f)); }
__device__ __forceinline__ float shx(float v, int mask, int lane) { return __builtin_bit_cast(float, __builtin_amdgcn_ds_bpermute((lane ^ mask) << 2, __builtin_bit_cast(int, v))); }
__device__ __forceinline__ float shup(float v, int d, int lane) { return __builtin_bit_cast(float, __builtin_amdgcn_ds_bpermute((lane - d) << 2, __builtin_bit_cast(int, v))); }
__device__ __forceinline__ float wave_sum(float v, int lane) {
#pragma unroll
    for (int o = 32; o >= 1; o >>= 1) v += shx(v, o, lane);
    return v;
}
__device__ __forceinline__ float wave_max(float v, int lane) {
#pragma unroll
    for (int o = 32; o >= 1; o >>= 1) v = fmaxf(v, shx(v, o, lane));
    return v;
}
#define DPP_F(old, v, ctrl, rmask) __builtin_bit_cast(float, __builtin_amdgcn_update_dpp(__builtin_bit_cast(int, (float)(old)), __builtin_bit_cast(int, (float)(v)), ctrl, rmask, 0xf, false))
__device__ __forceinline__ float wave_incl_sum(float v, int lane) {
    (void)lane;
    v += DPP_F(0.f, v, 0x111, 0xf); v += DPP_F(0.f, v, 0x112, 0xf); v += DPP_F(0.f, v, 0x114, 0xf); v += DPP_F(0.f, v, 0x118, 0xf);
    v += DPP_F(0.f, v, 0x142, 0xa);
    v += DPP_F(0.f, v, 0x143, 0xc);
    return v;
}
__device__ __forceinline__ float wave_incl_max(float v, int lane) {
    (void)lane;
    const float ninf = -INFINITY;
    v = fmaxf(v, DPP_F(ninf, v, 0x111, 0xf)); v = fmaxf(v, DPP_F(ninf, v, 0x112, 0xf)); v = fmaxf(v, DPP_F(ninf, v, 0x114, 0xf)); v = fmaxf(v, DPP_F(ninf, v, 0x118, 0xf));
    v = fmaxf(v, DPP_F(ninf, v, 0x142, 0xa));
    v = fmaxf(v, DPP_F(ninf, v, 0x143, 0xc));
    return v;
}
__device__ __forceinline__ float sum4(f32x4 a) { return (a[0] + a[1]) + (a[2] + a[3]); }
__device__ __forceinline__ float rowscale(const float* ssq, int row) {
    const float* s = ssq + (size_t)row * 16;
    const f32x4 a = *(const f32x4*)s, b = *(const f32x4*)(s + 4), c = *(const f32x4*)(s + 8), d = *(const f32x4*)(s + 12);
    const float t = (sum4(a) + sum4(b)) + (sum4(c) + sum4(d));
    return rsqrtf(t * (1.0f / 1024.0f) + EPS);
}
__device__ __forceinline__ int swz(int row, int ch) { return row * 256 + ((ch ^ (row & 15)) << 4); }

__device__ __forceinline__ void rtable_build(const float* ssq, int row_base, int wr, int wc, int fr, int fq, PG8_LAS float* rl) {
    const int lane = fq * 16 + fr, t = wc * 64 + lane, idx = t >> 1, hsel = t & 1;
    const int lrow = (idx >> 6) * 128 + wr * 64 + (idx & 63);
    const float* s = ssq + (size_t)(row_base + lrow) * 16 + hsel * 8;
    const f32x4 a = *(const f32x4*)s, b = *(const f32x4*)(s + 4);
    float v = sum4(a) + sum4(b);
    v += shx(v, 1, lane);
    if (hsel == 0) rl[lrow] = rsqrtf(v * (1.0f / 1024.0f) + EPS);
    asm volatile("s_waitcnt lgkmcnt(0)" ::: "memory"); __builtin_amdgcn_s_barrier(); asm volatile("" ::: "memory");
}
struct EpiProj {
    static constexpr bool PERM = true, AFTER_DRAIN = false, APERM = false;
    bf16_t* proj; const float* ssq; float* lnstat; PG8_LAS float* rl;
    __device__ __forceinline__ void operator()(const f32x4 (&acc)[2][2][4][2], const pg8::Unit& u, int wr, int wc, int fr_in, int fq_in) const {
        (void)fr_in; (void)fq_in; const int lane = otid() & 63, fr = lane & 15, fq = lane >> 4;
        const int row0 = u.pm * 256 + wr * 64 + fr, col0 = u.pn * 256 + wc * 32 + 8 * fq;
        const int mode = (u.pn == 4 || u.pn == 5) ? 2 : 3;
        rtable_build(ssq, u.pm * 256, wr, wc, fr, fq, rl);
#pragma unroll
        for (int ai = 0; ai < 2; ++ai)
#pragma unroll
            for (int m = 0; m < 4; ++m) {
                const int row = row0 + ai * 128 + m * 16;
                const float r = rl[ai * 128 + wr * 64 + m * 16 + fr];
                float s1 = 0.f, s2 = 0.f;
                bf16_t* rp = proj + (size_t)row * PROJ_LD + col0;
#pragma unroll
                for (int bj = 0; bj < 2; ++bj) {
                    f32x4 v0 = acc[ai][bj][m][0] * r, v1 = acc[ai][bj][m][1] * r;
                    if (mode == 0 || mode == 2) {
                        const f32x2 a = gelu_pk((f32x2){v0[0], v0[1]}), b = gelu_pk((f32x2){v0[2], v0[3]}), c = gelu_pk((f32x2){v1[0], v1[1]}), d = gelu_pk((f32x2){v1[2], v1[3]});
                        v0 = (f32x4){a.x, a.y, b.x, b.y}; v1 = (f32x4){c.x, c.y, d.x, d.y};
                    } else if (mode == 1) {
#pragma unroll
                        for (int j = 0; j < 4; ++j) { v0[j] = sigmoid_f(v0[j]); v1[j] = sigmoid_f(v1[j]); }
                    }
                    if (mode == 2) {
                        s1 += sum4(v0) + sum4(v1);
                        s2 += sum4(v0 * v0) + sum4(v1 * v1);
                    }
                    u32x4 w; w.x = cvt_pk_bf16(v0[0], v0[1]); w.y = cvt_pk_bf16(v0[2], v0[3]); w.z = cvt_pk_bf16(v1[0], v1[1]); w.w = cvt_pk_bf16(v1[2], v1[3]);
                    *(u32x4*)(rp + bj * 128) = w;
                }
                if (mode == 2) {
                    s1 += shx(s1, 16, lane); s1 += shx(s1, 32, lane);
                    s2 += shx(s2, 16, lane); s2 += shx(s2, 32, lane);
                    if (fq == 0) { float* st = lnstat + (size_t)row * 16 + ((u.pn - 4) * 4 + wc) * 2; st[0] = s1; st[1] = s2; }
                }
            }
    }
};
struct EpiResid {
    static constexpr bool PERM = true, AFTER_DRAIN = false, APERM = false;
    const float* xin; float* xout; bf16_t* xb; float* ssq; int row_off; int dry;
    __device__ __forceinline__ void operator()(const f32x4 (&acc)[2][2][4][2], const pg8::Unit& u, int wr, int wc, int fr_in, int fq_in) const {
        (void)fr_in; (void)fq_in; const int lane = otid() & 63, fr = lane & 15, fq = lane >> 4;
        const int row0 = row_off + u.pm * 256 + wr * 64 + fr, col0 = u.pn * 256 + wc * 32 + 8 * fq;
        f32x4 xa[2][2][2], xc[2][2][2];
#define RESID_LD(q, buf) do { _Pragma("unroll") for (int mm = 0; mm < 2; ++mm) _Pragma("unroll") for (int bj = 0; bj < 2; ++bj) { \
            const float* xi = xin + (size_t)(row0 + ((q) >> 1) * 128 + (((q) & 1) * 2 + mm) * 16) * DM + col0 + bj * 128; buf[mm][bj][0] = *(const f32x4*)xi; buf[mm][bj][1] = *(const f32x4*)(xi + 4); } } while (0)
#define RESID_ST(q, buf) do { _Pragma("unroll") for (int mm = 0; mm < 2; ++mm) { const int ai = (q) >> 1, m = ((q) & 1) * 2 + mm, row = row0 + ai * 128 + m * 16; const size_t base = (size_t)row * DM + col0; float s = 0.f; \
            _Pragma("unroll") for (int bj = 0; bj < 2; ++bj) { const f32x4 v0 = acc[ai][bj][m][0] + buf[mm][bj][0], v1 = acc[ai][bj][m][1] + buf[mm][bj][1]; float* xo = xout + base + bj * 128; \
                if (!dry) { *(f32x4*)xo = v0; *(f32x4*)(xo + 4) = v1; } s += sum4(v0 * v0) + sum4(v1 * v1); \
                u32x4 w; w.x = cvt_pk_bf16(v0[0], v0[1]); w.y = cvt_pk_bf16(v0[2], v0[3]); w.z = cvt_pk_bf16(v1[0], v1[1]); w.w = cvt_pk_bf16(v1[2], v1[3]); if (!dry) *(u32x4*)(xb + base + bj * 128) = w; } \
            s += shx(s, 16, lane); s += shx(s, 32, lane); if (fq == 0 && (!dry || s == 12345.678f)) ssq[(size_t)row * 16 + u.pn * 4 + wc] = s; } } while (0)
        RESID_LD(0, xa); RESID_LD(1, xc);
        RESID_ST(0, xa); RESID_LD(2, xa);
        RESID_ST(1, xc); RESID_LD(3, xc);
        RESID_ST(2, xa);
        RESID_ST(3, xc);
#undef RESID_LD
#undef RESID_ST
    }
};
__device__ __forceinline__ float dpp_ror1(float v) { return __builtin_bit_cast(float, __builtin_amdgcn_mov_dpp(__builtin_bit_cast(int, v), 0x121, 0xf, 0xf, true)); }
__device__ __forceinline__ float dpp_shr1(float v) { return __builtin_bit_cast(float, __builtin_amdgcn_mov_dpp(__builtin_bit_cast(int, v), 0x111, 0xf, 0xf, true)); }
__device__ __forceinline__ float dpp_ror2(float v) { return __builtin_bit_cast(float, __builtin_amdgcn_mov_dpp(__builtin_bit_cast(int, v), 0x122, 0xf, 0xf, true)); }
struct EpiUpAct {
    static constexpr bool PERM = true, AFTER_DRAIN = false, APERM = true;
    bf16_t* act; float* halo; const float* ssq; const float* cw; const float* cb; PG8_LAS float* rl;
    __device__ __forceinline__ void operator()(const f32x4 (&acc)[2][2][4][2], const pg8::Unit& u, int wr, int wc, int fr_in, int fq_in) const {
        (void)fr_in; (void)fq_in; const int lane = otid() & 63, fr = lane & 15, fq = lane >> 4;
        const int rowb = u.pm * 256 + wr * 64, ch0 = u.pn * 128 + wc * 32 + 8 * fq;
        PG8_LAS f32x4* wt = (PG8_LAS f32x4*)(rl + 256) + wr * 256;
        {
            const int t = wc * 64 + fq * 16 + fr, c = t >> 1, part = t & 1;
            const float* wp = cw + u.pn * 128 + c + part * DFF;
            f32x4 v; v[0] = wp[0]; v[1] = wp[UPN]; v[2] = wp[2 * UPN]; v[3] = cb[u.pn * 128 + c + part * DFF];
            wt[t] = v;
        }
        rtable_build(ssq, u.pm * 256, wr, wc, fr, fq, rl);
#pragma unroll
        for (int ai = 0; ai < 2; ++ai) {
            const int blk = (rowb + ai * 128) >> 6;
            if (fr == 0 || fr == 15) {
                const int mb = fr == 0 ? 0 : 2;
                const float ra = rl[ai * 128 + wr * 64 + 4 * fr + mb], rb2 = rl[ai * 128 + wr * 64 + 4 * fr + mb + 1];
                float* hp = halo + (size_t)(blk * 4 + mb) * UPN + ch0;
#pragma unroll
                for (int n = 0; n < 2; ++n) {
                    const f32x4 a0 = fr == 0 ? acc[ai][0][0][n] : acc[ai][0][2][n], a1 = fr == 0 ? acc[ai][0][1][n] : acc[ai][0][3][n];
                    const f32x4 b0 = fr == 0 ? acc[ai][1][0][n] : acc[ai][1][2][n], b1 = fr == 0 ? acc[ai][1][1][n] : acc[ai][1][3][n];
                    *(f32x4*)(hp + 4 * n) = a0 * ra; *(f32x4*)(hp + DFF + 4 * n) = b0 * ra;
                    *(f32x4*)(hp + UPN + 4 * n) = a1 * rb2; *(f32x4*)(hp + UPN + DFF + 4 * n) = b1 * rb2;
                }
            }
        }
        __builtin_amdgcn_sched_barrier(0);
#pragma unroll
        for (int ai = 0; ai < 2; ++ai) {
            const int rb = rowb + ai * 128;
            const f32x4 r4 = *(const PG8_LAS f32x4*)(rl + ai * 128 + wr * 64 + 4 * fr);
            unsigned pk[4][4];
#pragma unroll
            for (int n = 0; n < 2; ++n) {
                float oprev[4];
#pragma unroll
                for (int j = 0; j < 4; ++j) {
                    const int cl = wc * 32 + 8 * fq + 4 * n + j;
                    const f32x4 wa = wt[cl * 2], wb = wt[cl * 2 + 1];
                    float s[4];
                    {
                        float x[4];
#pragma unroll
                        for (int m = 0; m < 4; ++m) x[m] = acc[ai][0][m][n][j] * r4[m];
                        const float q3 = dpp_shr1(x[3]), q2 = dpp_shr1(x[2]);
                        s[0] = silu_f(wa[3] + wa[0] * q2 + wa[1] * q3 + wa[2] * x[0]);
                        s[1] = silu_f(wa[3] + wa[0] * q3 + wa[1] * x[0] + wa[2] * x[1]);
                        s[2] = silu_f(wa[3] + wa[0] * x[0] + wa[1] * x[1] + wa[2] * x[2]);
                        s[3] = silu_f(wa[3] + wa[0] * x[1] + wa[1] * x[2] + wa[2] * x[3]);
                    }
                    {
                        float x[4];
#pragma unroll
                        for (int m = 0; m < 4; ++m) x[m] = acc[ai][1][m][n][j] * r4[m];
                        const float q3 = dpp_shr1(x[3]), q2 = dpp_shr1(x[2]);
                        s[0] *= wb[3] + wb[0] * q2 + wb[1] * q3 + wb[2] * x[0];
                        s[1] *= wb[3] + wb[0] * q3 + wb[1] * x[0] + wb[2] * x[1];
                        s[2] *= wb[3] + wb[0] * x[0] + wb[1] * x[1] + wb[2] * x[2];
                        s[3] *= wb[3] + wb[0] * x[1] + wb[1] * x[2] + wb[2] * x[3];
                    }
#pragma unroll
                    for (int m = 0; m < 4; ++m) { if (j & 1) pk[m][2 * n + (j >> 1)] = cvt_pk_bf16(oprev[m], s[m]); else oprev[m] = s[m]; }
                    __builtin_amdgcn_sched_barrier(0);
                }
            }
#pragma unroll
            for (int m = 0; m < 4; ++m) {
                if (m > 1 || fr > 0) { u32x4 w; w.x = pk[m][0]; w.y = pk[m][1]; w.z = pk[m][2]; w.w = pk[m][3]; *(u32x4*)(act + (size_t)(rb + 4 * fr + m) * DFF + ch0) = w; }
            }
        }
    }
};
struct EpiPe {
    static constexpr bool PERM = true, AFTER_DRAIN = false, APERM = false;
    bf16_t* pe;
    __device__ __forceinline__ void operator()(const f32x4 (&acc)[2][2][4][2], const pg8::Unit& u, int wr, int wc, int fr_in, int fq_in) const {
        (void)fr_in; (void)fq_in; const int lane = otid() & 63, fr = lane & 15, fq = lane >> 4;
        const int row0 = u.pm * 256 + wr * 64 + fr, col0 = u.pn * 256 + wc * 32 + 8 * fq;
#pragma unroll
        for (int ai = 0; ai < 2; ++ai)
#pragma unroll
            for (int m = 0; m < 4; ++m) {
                const int row = row0 + ai * 128 + m * 16;
                bf16_t* rp = pe + (size_t)row * DM + col0;
#pragma unroll
                for (int bj = 0; bj < 2; ++bj) {
                    const f32x4 v0 = acc[ai][bj][m][0], v1 = acc[ai][bj][m][1];
                    u32x4 w; w.x = cvt_pk_bf16(v0[0], v0[1]); w.y = cvt_pk_bf16(v0[2], v0[3]); w.z = cvt_pk_bf16(v1[0], v1[1]); w.w = cvt_pk_bf16(v1[2], v1[3]);
                    *(u32x4*)(rp + bj * 128) = w;
                }
            }
    }
};
struct EpiGate {
    static constexpr bool PERM = true, AFTER_DRAIN = false, APERM = false;
    float* x; const bf16_t* pe; const float* ssq_in; bf16_t* xb; float* ssq; PG8_LAS float* rl; int dry;
    __device__ __forceinline__ void operator()(const f32x4 (&acc)[2][2][4][2], const pg8::Unit& u, int wr, int wc, int fr_in, int fq_in) const {
        (void)fr_in; (void)fq_in; const int lane = otid() & 63, fr = lane & 15, fq = lane >> 4;
        const int row0 = u.pm * 256 + wr * 64 + fr, col0 = u.pn * 256 + wc * 32 + 8 * fq;
        rtable_build(ssq_in, u.pm * 256, wr, wc, fr, fq, rl);
        f32x4 xa[2][2][2]; u32x4 pa[2][2];
#define GATE_LD(q, buf, pbuf) do { _Pragma("unroll") for (int mm = 0; mm < 2; ++mm) _Pragma("unroll") for (int bj = 0; bj < 2; ++bj) { \
            const size_t off = (size_t)(row0 + ((q) >> 1) * 128 + (((q) & 1) * 2 + mm) * 16) * DM + col0 + bj * 128; buf[mm][bj][0] = *(const f32x4*)(x + off); buf[mm][bj][1] = *(const f32x4*)(x + off + 4); pbuf[mm][bj] = *(const u32x4*)(pe + off); } } while (0)
#define GATE_ST(q, buf, pbuf) do { _Pragma("unroll") for (int mm = 0; mm < 2; ++mm) { const int ai = (q) >> 1, m = ((q) & 1) * 2 + mm, row = row0 + ai * 128 + m * 16; const size_t base = (size_t)row * DM + col0; float s = 0.f; \
            const float r = rl[ai * 128 + wr * 64 + m * 16 + fr]; \
            _Pragma("unroll") for (int bj = 0; bj < 2; ++bj) { f32x4 g0 = acc[ai][bj][m][0] * r, g1 = acc[ai][bj][m][1] * r; \
                _Pragma("unroll") for (int j = 0; j < 4; ++j) { g0[j] = sigmoid_f(g0[j]); g1[j] = sigmoid_f(g1[j]); } \
                const u32x4 pv = pbuf[mm][bj]; const f32x4 p0 = (f32x4){bflo(pv.x), bfhi(pv.x), bflo(pv.y), bfhi(pv.y)}, p1 = (f32x4){bflo(pv.z), bfhi(pv.z), bflo(pv.w), bfhi(pv.w)}; \
                const f32x4 v0 = buf[mm][bj][0] + g0 * p0, v1 = buf[mm][bj][1] + g1 * p1; float* xo = x + base + bj * 128; \
                if (!dry) { *(f32x4*)xo = v0; *(f32x4*)(xo + 4) = v1; } s += sum4(v0 * v0) + sum4(v1 * v1); \
                u32x4 w; w.x = cvt_pk_bf16(v0[0], v0[1]); w.y = cvt_pk_bf16(v0[2], v0[3]); w.z = cvt_pk_bf16(v1[0], v1[1]); w.w = cvt_pk_bf16(v1[2], v1[3]); if (!dry) *(u32x4*)(xb + base + bj * 128) = w; } \
            s += shx(s, 16, lane); s += shx(s, 32, lane); if (fq == 0 && (!dry || s == 12345.678f)) ssq[(size_t)row * 16 + u.pn * 4 + wc] = s; } } while (0)
        GATE_LD(0, xa, pa); GATE_ST(0, xa, pa);
        GATE_LD(1, xa, pa); GATE_ST(1, xa, pa);
        GATE_LD(2, xa, pa); GATE_ST(2, xa, pa);
        GATE_LD(3, xa, pa); GATE_ST(3, xa, pa);
#undef GATE_LD
#undef GATE_ST
    }
};

template <class Epi>
__device__ __forceinline__ void run_gemm(ldsp lds, const bf16_t* A, int lda, const bf16_t* Bt, int M, int N, int K, const Epi& E) {
    pg8::Gemm g; g.A = A; g.Bt = Bt; g.M = M; g.N = N; g.K = K; g.lda = lda;
    pg8::StaticOrder S; S.init(M, N, (int)gridDim.x, obid());
    pg8::gemm_phase<Epi, pg8::StaticOrder>(lds, g, S, E);
}

__device__ __forceinline__ void tr_tile(ldsp lds, const float* __restrict__ src, int ld, int c0, int k0, const float* __restrict__ g, bf16_t* __restrict__ dst, int Kd, int n0) {
    PG8_LAS float* tile = (PG8_LAS float*)lds;
    const int tid = otid();
#pragma unroll
    for (int i = 0; i < 2; ++i) {
        const int q = tid + i * 512, kr = q >> 4, c4 = (q & 15) * 4;
        const f32x4 v = *(const f32x4*)(src + (size_t)(k0 + kr) * ld + c0 + c4);
        const float s = g ? g[k0 + kr] : 1.f;
        tile[kr * 65 + c4 + 0] = v[0] * s; tile[kr * 65 + c4 + 1] = v[1] * s; tile[kr * 65 + c4 + 2] = v[2] * s; tile[kr * 65 + c4 + 3] = v[3] * s;
    }
    __syncthreads();
    {
        const int n = tid >> 3, kc = (tid & 7) * 8;
        float f[8];
#pragma unroll
        for (int j = 0; j < 8; ++j) f[j] = tile[(kc + j) * 65 + n];
        u32x4 w; w.x = cvt_pk_bf16(f[0], f[1]); w.y = cvt_pk_bf16(f[2], f[3]); w.z = cvt_pk_bf16(f[4], f[5]); w.w = cvt_pk_bf16(f[6], f[7]);
        *(u32x4*)(dst + (size_t)(n0 + n) * Kd + k0 + kc) = w;
    }
    __syncthreads();
}

__device__ __forceinline__ void prep_phase(ldsp lds, KP p) {
    const int tid = otid(), lane = tid & 63, w = __builtin_amdgcn_readfirstlane(tid >> 6);
    unsigned char* ws = p->ws;
    for (int j = obid(); j < 4 * 3456; j += gridDim.x) {
        const int l = j / 3456; int r = j % 3456;
        unsigned char* wt = ws + WS_WT + (size_t)l * WT_LAYER;
        const float* src; const float* g = nullptr; bf16_t* dst; int ld, c0, k0, Kd, n0;
        if (r < 768) { const int kt = r & 15, nt = r >> 4; n0 = nt * 64; k0 = kt * 64; src = p->in[3] + (size_t)l * 1024 * 3080; ld = 3080; c0 = n0 < 512 ? n0 : (n0 < 1024 ? n0 + 2048 : n0 - 512); g = p->in[2] + l * 1024; dst = (bf16_t*)(wt + WT_IN); Kd = 1024; }
        else if (r < 1024) { r -= 768; const int kt = r & 15, nt = r >> 4; n0 = nt * 64; k0 = kt * 64; src = p->in[13] + (size_t)l * 1024 * 1024; ld = 1024; c0 = n0; dst = (bf16_t*)(wt + WT_OUT); Kd = 1024; }
        else if (r < 2432) { r -= 1024; const int kt = r & 15, nt = r >> 4; n0 = nt * 64; k0 = kt * 64; src = p->in[15] + (size_t)l * 1024 * 5632; ld = 5632; c0 = ((n0 & 255) >> 7) * DFF + (n0 >> 8) * 128 + (n0 & 127); g = p->in[14] + l * 1024; dst = (bf16_t*)(wt + WT_UP); Kd = 1024; }
        else if (r < 3136) { r -= 2432; const int kt = r % 44, nt = r / 44; n0 = nt * 64; k0 = kt * 64; src = p->in[18] + (size_t)l * 2816 * 1024; ld = 1024; c0 = n0; dst = (bf16_t*)(wt + WT_DOWN); Kd = 2816; }
        else if (r < 3392) { r -= 3136; const int kt = r & 15, nt = r >> 4; n0 = nt * 64; k0 = kt * 64; src = p->in[20] + (size_t)l * 1024 * 1024; ld = 1024; c0 = n0; g = p->in[19] + l * 1024; dst = (bf16_t*)(wt + WT_GATE); Kd = 1024; }
        else { r -= 3392; const int kt = r & 3, nt = r >> 2; n0 = nt * 64; k0 = kt * 64; src = p->in[21] + (size_t)l * 256 * 1024; ld = 1024; c0 = n0; dst = (bf16_t*)(wt + WT_PLE); Kd = 256; }
        tr_tile(lds, src, ld, c0, k0, g, dst, Kd, n0);
    }
    const int gtid = obid() * 512 + tid, gthreads = gridDim.x * 512;
    for (int i = gtid; i < 4 * 8 * 128 * 16; i += gthreads) {
        const int l = i >> 14, rem = i & 16383, h = rem >> 11, t = (rem >> 4) & 127, s0 = (rem & 15) * 8;
        const float* src = p->in[6] + (size_t)i * 8;
        const f32x4 a = *(const f32x4*)src, b = *(const f32x4*)(src + 4);
        float f[8] = {a[0], a[1], a[2], a[3], b[0], b[1], b[2], b[3]};
#pragma unroll
        for (int j = 0; j < 8; ++j) f[j] = (s0 + j <= t) ? f[j] : 0.f;
        u32x4 wv; wv.x = cvt_pk_bf16(f[0], f[1]); wv.y = cvt_pk_bf16(f[2], f[3]); wv.z = cvt_pk_bf16(f[4], f[5]); wv.w = cvt_pk_bf16(f[6], f[7]);
        bf16_t* dst = (bf16_t*)(ws + WS_WT + (size_t)l * WT_LAYER + WT_WSB) + (size_t)(h * 128 + t) * 128 + s0;
        *(u32x4*)dst = wv;
    }
    for (int i = gtid; i < 4 * 1024 * 8; i += gthreads) {
        const int l = i >> 13, k = (i >> 3) & 1023, j = i & 7;
        ((float*)(ws + WS_WG))[i] = p->in[3][((size_t)l * 1024 + k) * 3080 + 3072 + j] * p->in[2][l * 1024 + k];
    }
    bf16_t* xb0 = (bf16_t*)(ws + WS_XB0); float* ssq0 = (float*)(ws + WS_SSQ0);
    for (int rowb = obid() * 8 + w; rowb < NTOK; rowb += gridDim.x * 8 * 4) {
        const int rstep = gridDim.x * 8;
        f32x4 xv[4][4];
#pragma unroll
        for (int u = 0; u < 4; ++u) { const int row = rowb + u * rstep < NTOK ? rowb + u * rstep : rowb;
#pragma unroll
            for (int i = 0; i < 4; ++i) xv[u][i] = *(const f32x4*)(p->in[0] + (size_t)row * DM + i * 256 + lane * 4); }
#pragma unroll
        for (int u = 0; u < 4; ++u) {
            const int row = rowb + u * rstep; float s = 0.f;
            if (row < NTOK) {
#pragma unroll
                for (int i = 0; i < 4; ++i) {
                    const f32x4 v = xv[u][i]; s += sum4(v * v);
                    u32x2 pk; pk.x = cvt_pk_bf16(v[0], v[1]); pk.y = cvt_pk_bf16(v[2], v[3]);
                    *(u32x2*)(xb0 + (size_t)row * DM + i * 256 + lane * 4) = pk;
                }
                s = wave_sum(s, lane);
                if (lane < 16) ssq0[(size_t)row * 16 + lane] = lane == 0 ? s : 0.f;
            }
        }
    }
}

__device__ __forceinline__ void gates_phase(ldsp lds, KP p, int l, const bf16_t* xb, const float* ssq, int part) {
    const int tid = otid(), lane = tid & 63, w = __builtin_amdgcn_readfirstlane(tid >> 6), fr = lane & 15, fq = lane >> 4;
    ldsp wt = lds;
    const float* wg = (const float*)(p->ws + WS_WG) + l * 8192;
    {
        const int k0 = tid * 2;
        const f32x4 a0 = *(const f32x4*)(wg + k0 * 8), a1 = *(const f32x4*)(wg + k0 * 8 + 4), b0 = *(const f32x4*)(wg + k0 * 8 + 8), b1 = *(const f32x4*)(wg + k0 * 8 + 12);
        const float v0[8] = {a0[0], a0[1], a0[2], a0[3], a1[0], a1[1], a1[2], a1[3]}, v1[8] = {b0[0], b0[1], b0[2], b0[3], b1[0], b1[1], b1[2], b1[3]};
#pragma unroll
        for (int n = 0; n < 8; ++n) {
            *(PG8_LAS unsigned*)(wt + n * 2048 + ((((k0 >> 3) ^ n) & 127) << 4) + (k0 & 7) * 2) = cvt_pk_bf16(v0[n], v1[n]);
            *(PG8_LAS unsigned*)(wt + (n + 8) * 2048 + ((((k0 >> 3) ^ (n + 8)) & 127) << 4) + (k0 & 7) * 2) = 0u;
        }
    }
    __syncthreads();
    float* gates = (float*)(p->ws + WS_GATES);
    int G8 = (int)gridDim.x * 8; asm volatile("" : "+s"(G8));
    const int nblk = NTOK / 16, per = (nblk + G8 - 1) / G8;
    const int b_lo = part == 1 ? per / 2 : 0, b_hi = part == 0 ? per / 2 : per;
    for (int bi = b_lo; bi < b_hi; ++bi) {
        const int blk = (obid() * 8 + w) * per + bi;
        if (blk >= nblk) break;
        const int row = blk * 16 + fr;
        const bf16_t* xr = xb + (size_t)row * DM + fq * 8;
        const float r = rowscale(ssq, row);
        f32x4 acc = (f32x4){0.f, 0.f, 0.f, 0.f};
#pragma unroll
        for (int kb = 0; kb < 4; ++kb) {
            bf16x8 a[8];
#pragma unroll
            for (int i = 0; i < 8; ++i) a[i] = *(const bf16x8*)(xr + (kb * 8 + i) * 32);
#pragma unroll
            for (int i = 0; i < 8; ++i) {
                const int ch = (kb * 8 + i) * 4 + fq;
                const bf16x8 b = *(const PG8_LAS bf16x8*)(wt + fr * 2048 + (((ch ^ fr) & 127) << 4));
                acc = __builtin_amdgcn_mfma_f32_16x16x32_bf16(b, a[i], acc, 0, 0, 0);
            }
        }
        if (fq < 2) {
            f32x4 o;
#pragma unroll
            for (int j = 0; j < 4; ++j) {
                const float z = r * acc[j] + (fq == 0 ? p->in[10][l * 4 + j] : p->in[11][l * 4 + j]);
                o[j] = fq == 0 ? z : fminf(z, 0.f) - __logf(1.0f + __expf(-fabsf(z)));
            }
            *(f32x4*)(gates + (size_t)row * 8 + fq * 4) = o;
        }
    }
    __syncthreads();
}

template <int NT>
__device__ __forceinline__ void strip_mma(ldsp A, int arow0, ldsp Bt, f32x4 (&acc)[NT], int lane, int kk_lo, int kk_hi, int nt_hi) {
    const int fr = lane & 15, fq = lane >> 4;
    for (int kk = kk_lo; kk < kk_hi; ++kk) {
        const int ch = kk * 4 + fq;
        const bf16x8 a = *(const PG8_LAS bf16x8*)(A + swz(arow0 + fr, ch));
#pragma unroll
        for (int nt = 0; nt < NT; ++nt) if (nt < nt_hi) {
            const bf16x8 b = *(const PG8_LAS bf16x8*)(Bt + swz(nt * 16 + fr, ch));
            acc[nt] = __builtin_amdgcn_mfma_f32_16x16x32_bf16(b, a, acc[nt], 0, 0, 0);
        }
    }
}

__device__ __forceinline__ void gmlp_task(ldsp lds, KP p, int l, int task, bool dry = false) {
    const int c = task >> 3, h = task & 7, tok0 = c * 128;
    const int tid = otid(), lane = tid & 63, w = __builtin_amdgcn_readfirstlane(tid >> 6);
    ldsp W = lds, VT = lds + 32768;
    bf16_t* proj = (bf16_t*)(p->ws + WS_PROJ);
    const bf16_t* wsb = (const bf16_t*)(p->ws + WS_WT + (size_t)l * WT_LAYER + WT_WSB) + (size_t)h * 16384;
    u32x4 wreg[4];
#pragma unroll
    for (int i = 0; i < 4; ++i) { const int q = tid + i * 512, row = q >> 4, ch = q & 15; wreg[i] = *(const u32x4*)(wsb + row * 128 + ch * 8); }
    {
        const int s = tid >> 2, cb = (tid & 3) * 16, tok = tok0 + s;
        const float* st = (const float*)(p->ws + WS_LNSTAT) + (size_t)tok * 16;
        const f32x4 a = *(const f32x4*)st, b = *(const f32x4*)(st + 4), c2 = *(const f32x4*)(st + 8), d = *(const f32x4*)(st + 12);
        const float s1 = (a[0] + a[2]) + (b[0] + b[2]) + (c2[0] + c2[2]) + (d[0] + d[2]);
        const float s2 = (a[1] + a[3]) + (b[1] + b[3]) + (c2[1] + c2[3]) + (d[1] + d[3]);
        const float mu = s1 * (1.0f / 512.0f), var = fmaxf(s2 * (1.0f / 512.0f) - mu * mu, 0.f), rstd = rsqrtf(var + EPS);
        const bf16_t* src = proj + (size_t)tok * PROJ_LD + 1024 + h * 64 + cb;
        const u32x4 r0 = *(const u32x4*)src, r1 = *(const u32x4*)(src + 8);
        const unsigned rw[8] = {r0.x, r0.y, r0.z, r0.w, r1.x, r1.y, r1.z, r1.w};
        const float* lgp = p->in[4] + l * 512 + h * 64 + cb; const float* lbp = p->in[5] + l * 512 + h * 64 + cb;
        const f32x4 g0 = *(const f32x4*)lgp, g1 = *(const f32x4*)(lgp + 4), g2 = *(const f32x4*)(lgp + 8), g3 = *(const f32x4*)(lgp + 12);
        const f32x4 b0 = *(const f32x4*)lbp, b1 = *(const f32x4*)(lbp + 4), b2 = *(const f32x4*)(lbp + 8), b3 = *(const f32x4*)(lbp + 12);
        const float lg[16] = {g0[0], g0[1], g0[2], g0[3], g1[0], g1[1], g1[2], g1[3], g2[0], g2[1], g2[2], g2[3], g3[0], g3[1], g3[2], g3[3]};
        const float lb[16] = {b0[0], b0[1], b0[2], b0[3], b1[0], b1[1], b1[2], b1[3], b2[0], b2[1], b2[2], b2[3], b3[0], b3[1], b3[2], b3[3]};
#pragma unroll
        for (int j = 0; j < 16; ++j) {
            const float x = (j & 1) ? bfhi(rw[j >> 1]) : bflo(rw[j >> 1]);
            const float y = (x - mu) * rstd * lg[j] + lb[j];
            const int dd = cb + j;
            *(PG8_LAS bf16_t*)(VT + dd * 256 + (((s >> 3) ^ (dd & 15)) << 4) + (s & 7) * 2) = f2bf(y);
        }
    }
#pragma unroll
    for (int i = 0; i < 4; ++i) { const int q = tid + i * 512, row = q >> 4, ch = q & 15; *(PG8_LAS u32x4*)(W + swz(row, ch)) = wreg[i]; }
    u32x2 uup[4]; float bs;
    {
        const int t = 16 * w + (lane & 15), tok = tok0 + t, fq = lane >> 4;
        bs = p->in[7][(l * 8 + h) * 128 + t];
#pragma unroll
        for (int nt = 0; nt < 4; ++nt) uup[nt] = *(const u32x2*)(proj + (size_t)tok * PROJ_LD + h * 64 + nt * 16 + fq * 4);
    }
    __syncthreads();
    f32x4 acc[4];
#pragma unroll
    for (int i = 0; i < 4; ++i) acc[i] = (f32x4){0.f, 0.f, 0.f, 0.f};
    const int kk_hi = (16 * w + 15) / 32 + 1;
    strip_mma<4>(W, 16 * w, VT, acc, lane, 0, kk_hi, 4);
    {
        const int t = 16 * w + (lane & 15), tok = tok0 + t, fq = lane >> 4;
#pragma unroll
        for (int nt = 0; nt < 4; ++nt) {
            bf16_t* up = proj + (size_t)tok * PROJ_LD + h * 64 + nt * 16 + fq * 4;
            const u32x2 uu = uup[nt];
            const f32x2 g0 = gelu_pk((f32x2){bflo(uu.x), bfhi(uu.x)}), g1 = gelu_pk((f32x2){bflo(uu.y), bfhi(uu.y)});
            u32x2 o; o.x = cvt_pk_bf16(g0.x * (acc[nt][0] + bs), g0.y * (acc[nt][1] + bs)); o.y = cvt_pk_bf16(g1.x * (acc[nt][2] + bs), g1.y * (acc[nt][3] + bs));
            if (!dry) *(u32x2*)up = o;
        }
    }
    __syncthreads();
}

__device__ __forceinline__ void conv_table_fill(PG8_LAS float* wts, const float* cw, const float* cb, int h, int tid) {
    if (tid < 320) {
        const int part = tid >> 6, c4 = (tid & 63) * 4, gch = c4 < 128 ? h * 128 + c4 : 512 + h * 128 + (c4 - 128);
        const f32x4 v = part < 4 ? *(const f32x4*)(cw + part * 1024 + gch) : *(const f32x4*)(cb + gch);
        *(PG8_LAS f32x4*)(wts + part * 256 + c4) = v;
    }
}
__device__ __forceinline__ void conv_rows_load(const bf16_t* proj, int tok, int spos, int col, u32x4 (&r)[4][2]) {
#pragma unroll
    for (int jj = 0; jj < 4; ++jj) {
        const bf16_t* src = proj + (size_t)(spos - 3 + jj >= 0 ? tok - 3 + jj : tok) * PROJ_LD + col;
        r[jj][0] = *(const u32x4*)src; r[jj][1] = *(const u32x4*)(src + 8);
    }
}
__device__ __forceinline__ void conv16_regs(const u32x4 (&r)[4][2], int spos, const PG8_LAS float* wts, int lc0, float (&o)[16]) {
#pragma unroll
    for (int q = 0; q < 4; ++q) { const f32x4 b = *(const PG8_LAS f32x4*)(wts + 4 * 256 + lc0 + q * 4); o[q * 4 + 0] = b[0]; o[q * 4 + 1] = b[1]; o[q * 4 + 2] = b[2]; o[q * 4 + 3] = b[3]; }
#pragma unroll
    for (int jj = 0; jj < 4; ++jj) {
        const float vm = spos - 3 + jj >= 0 ? 1.f : 0.f;
        const unsigned rw[8] = {r[jj][0].x, r[jj][0].y, r[jj][0].z, r[jj][0].w, r[jj][1].x, r[jj][1].y, r[jj][1].z, r[jj][1].w};
#pragma unroll
        for (int q = 0; q < 4; ++q) {
            const f32x4 wv = *(const PG8_LAS f32x4*)(wts + jj * 256 + lc0 + q * 4) * vm;
            o[q * 4 + 0] += wv[0] * bflo(rw[q * 2]); o[q * 4 + 1] += wv[1] * bfhi(rw[q * 2]);
            o[q * 4 + 2] += wv[2] * bflo(rw[q * 2 + 1]); o[q * 4 + 3] += wv[3] * bfhi(rw[q * 2 + 1]);
        }
    }
#pragma unroll
    for (int j = 0; j < 16; ++j) o[j] = silu_f(o[j]);
}

__device__ __forceinline__ void mlstm_dc_task(ldsp lds, KP p, int l, int cidx) {
    const int n = cidx & 127, bh = cidx >> 7, h = bh & 3, b = bh >> 2, tok0 = b * SEQ + n * 128;
    const int tid = otid(), lane = tid & 63, w = __builtin_amdgcn_readfirstlane(tid >> 6);
    ldsp KT = lds, VT = lds + 32768; PG8_LAS float* wl = (PG8_LAS float*)(lds + 131072);
    const bf16_t* proj = (const bf16_t*)(p->ws + WS_PROJ);
    const float* gates = (const float*)(p->ws + WS_GATES);
    PG8_LAS float* wts = (PG8_LAS float*)(lds + 131072 + 2560);
    conv_table_fill(wts, p->in[8] + (size_t)l * 4096, p->in[9] + l * 1024, h, tid);
    const int lr = tid >> 2, cb = (tid & 3) * 32, tok = tok0 + lr, spos = n * 128 + lr;
    u32x4 rk[2][4][2], rv[2][2];
#pragma unroll
    for (int hf = 0; hf < 2; ++hf) {
        const int c0 = cb + hf * 16;
        conv_rows_load(proj, tok, spos, 2048 + h * 128 + c0, rk[hf]);
        const bf16_t* vs = proj + (size_t)tok * PROJ_LD + 2560 + h * 128 + c0;
        rv[hf][0] = *(const u32x4*)vs; rv[hf][1] = *(const u32x4*)(vs + 8);
    }
    if (w == 0) {
        const int l0 = 2 * lane;
        const float ig0 = gates[(size_t)(tok0 + l0) * 8 + h], lf0 = gates[(size_t)(tok0 + l0) * 8 + 4 + h];
        const float ig1 = gates[(size_t)(tok0 + l0 + 1) * 8 + h], lf1 = gates[(size_t)(tok0 + l0 + 1) * 8 + 4 + h];
        const float incl = wave_incl_sum(lf0 + lf1, lane);
        const float b1 = incl, b0 = incl - lf1, bL = __builtin_bit_cast(float, __builtin_amdgcn_readlane(__builtin_bit_cast(int, incl), 63));
        const float a0 = bL - b0 + ig0, a1 = bL - b1 + ig1;
        const float amax = wave_max(fmaxf(a0, a1), lane);
        wl[l0] = __expf(a0 - amax); wl[l0 + 1] = __expf(a1 - amax);
        if (lane == 0) { ((float*)(p->ws + WS_CHBL))[cidx] = bL; ((float*)(p->ws + WS_CHAMAX))[cidx] = amax; }
    }
    __syncthreads();
    {
        const float wgt = wl[lr] * 0.08838834764831845f;
#pragma unroll
        for (int hf = 0; hf < 2; ++hf) {
            const int c0 = cb + hf * 16;
            float o[16];
            conv16_regs(rk[hf], spos, wts, 128 + c0, o);
#pragma unroll
            for (int j = 0; j < 16; ++j) { const int d = c0 + j; *(PG8_LAS bf16_t*)(KT + d * 256 + (((lr >> 3) ^ (d & 15)) << 4) + (lr & 7) * 2) = f2bf(o[j] * wgt); }
            const unsigned rw[8] = {rv[hf][0].x, rv[hf][0].y, rv[hf][0].z, rv[hf][0].w, rv[hf][1].x, rv[hf][1].y, rv[hf][1].z, rv[hf][1].w};
#pragma unroll
            for (int j = 0; j < 16; ++j) { const int e = c0 + j; const unsigned v16 = (j & 1) ? (rw[j >> 1] >> 16) : (rw[j >> 1] & 0xffffu);
                *(PG8_LAS bf16_t*)(VT + e * 256 + (((lr >> 3) ^ (e & 15)) << 4) + (lr & 7) * 2) = (bf16_t)v16; }
        }
    }
    __syncthreads();
    if (tid < 128) {
        const int d = tid; float s = 0.f;
#pragma unroll
        for (int pc = 0; pc < 16; ++pc) {
            const u32x4 v = *(const PG8_LAS u32x4*)(KT + d * 256 + ((pc ^ (d & 15)) << 4));
            s += (bflo(v.x) + bfhi(v.x)) + (bflo(v.y) + bfhi(v.y)) + (bflo(v.z) + bfhi(v.z)) + (bflo(v.w) + bfhi(v.w));
        }
        ((float*)(p->ws + WS_DN))[(size_t)cidx * 128 + d] = s;
    }
    f32x4 acc[8];
#pragma unroll
    for (int i = 0; i < 8; ++i) acc[i] = (f32x4){0.f, 0.f, 0.f, 0.f};
    strip_mma<8>(VT, 16 * w, KT, acc, lane, 0, 4, 8);
    {
        const int e = 16 * w + (lane & 15), fq = lane >> 4;
        bf16_t* dst = (bf16_t*)(p->ws + WS_DC) + ((size_t)cidx * 128 + e) * 128 + fq * 4;
#pragma unroll
        for (int nt = 0; nt < 8; ++nt) { u32x2 o; o.x = cvt_pk_bf16(acc[nt][0], acc[nt][1]); o.y = cvt_pk_bf16(acc[nt][2], acc[nt][3]); *(u32x2*)(dst + nt * 16) = o; }
    }
    __syncthreads();
}

__device__ __forceinline__ void scan_phase(KP p, bool dry = false) {
    const int gtid = obid() * 512 + otid(), gthreads = gridDim.x * 512;
    const float* __restrict__ chbl = (const float*)(p->ws + WS_CHBL); const float* __restrict__ cham = (const float*)(p->ws + WS_CHAMAX);
    float* m0 = (float*)(p->ws + WS_CHM0);
    for (int idx = gtid; idx < 8 * 16384; idx += gthreads) {
        const int bh = idx >> 14, el = idx & 16383;
        bf16_t* ptr = (bf16_t*)(p->ws + WS_DC) + (size_t)bh * 128 * 16384 + el;
        const bool hasn = idx < 1024;
        const int bh2 = (idx >> 7) & 7, d2 = idx & 127;
        float* nptr = (float*)(p->ws + WS_DN) + (size_t)bh2 * 128 * 128 + d2;
        float C = 0.f, m = 0.f, nv = 0.f, m2 = 0.f;
        for (int c0 = 0; c0 < 128; c0 += 16) {
            float d[16], bl[16], am[16], dn[16], bl2[16], am2[16];
#pragma unroll
            for (int u = 0; u < 16; ++u) { d[u] = bf2f(ptr[(size_t)(c0 + u) * 16384]); bl[u] = chbl[bh * 128 + c0 + u]; am[u] = cham[bh * 128 + c0 + u]; }
            if (hasn) {
#pragma unroll
                for (int u = 0; u < 16; ++u) { dn[u] = nptr[(c0 + u) * 128]; bl2[u] = chbl[bh2 * 128 + c0 + u]; am2[u] = cham[bh2 * 128 + c0 + u]; }
            }
#pragma unroll
            for (int u = 0; u < 16; ++u) {
                const float mn = fmaxf(bl[u] + m, am[u]), dec = __expf(bl[u] + m - mn), sc = __expf(am[u] - mn);
                if (!dry) ptr[(size_t)(c0 + u) * 16384] = f2bf(C);
                C = dec * C + sc * d[u]; m = mn;
            }
            if (hasn) {
#pragma unroll
                for (int u = 0; u < 16; ++u) {
                    const float mn = fmaxf(bl2[u] + m2, am2[u]), dec = __expf(bl2[u] + m2 - mn), sc = __expf(am2[u] - mn);
                    if (!dry) { nptr[(c0 + u) * 128] = nv;
                    if (d2 == 0) m0[bh2 * 128 + c0 + u] = m2; }
                    nv = dec * nv + sc * dn[u]; m2 = mn;
                }
            }
        }
        if (dry && C == 12345.678f && nv == 3.25f) m0[0] = C + nv + m + m2;
    }
}

__device__ __forceinline__ void mlstm_out_task(ldsp lds, KP p, int l, int cidx, bool dry = false) {
    const int n = cidx & 127, bh = cidx >> 7, h = bh & 3, b = bh >> 2, tok0 = b * SEQ + n * 128;
    const int tid = otid(), lane = tid & 63, w = __builtin_amdgcn_readfirstlane(tid >> 6), fr = lane & 15, fq = lane >> 4;
    ldsp Q = lds, KP = lds + 32768, VT = lds + 65536, CT = lds + 98304;
    PG8_LAS float* gA = (PG8_LAS float*)(lds + 131072); PG8_LAS float* MA = gA + 128; PG8_LAS float* bA = gA + 256; PG8_LAS float* dq = gA + 384; PG8_LAS float* n0s = gA + 512;
    bf16_t* proj = (bf16_t*)(p->ws + WS_PROJ);
    const float* gates = (const float*)(p->ws + WS_GATES);
    const float m0 = ((const float*)(p->ws + WS_CHM0))[cidx];
    if (w == 0) {
        const int l0 = 2 * lane;
        const float ig0 = gates[(size_t)(tok0 + l0) * 8 + h], lf0 = gates[(size_t)(tok0 + l0) * 8 + 4 + h];
        const float ig1 = gates[(size_t)(tok0 + l0 + 1) * 8 + h], lf1 = gates[(size_t)(tok0 + l0 + 1) * 8 + 4 + h];
        const float incl = wave_incl_sum(lf0 + lf1, lane);
        const float b1 = incl, b0 = incl - lf1;
        const float g0 = ig0 - b0, g1 = ig1 - b1;
        const float pm = wave_incl_max(fmaxf(g0, g1), lane);
        float ex = shup(pm, 1, lane); if (lane == 0) ex = -INFINITY;
        const float pm0 = fmaxf(ex, g0), pm1 = pm;
        gA[l0] = g0; gA[l0 + 1] = g1; bA[l0] = b0; bA[l0 + 1] = b1;
        MA[l0] = fmaxf(pm0, m0); MA[l0 + 1] = fmaxf(pm1, m0);
    }
    if (tid >= 128 && tid < 256) n0s[tid - 128] = ((const float*)(p->ws + WS_DN))[(size_t)cidx * 128 + tid - 128];
    PG8_LAS float* wts = (PG8_LAS float*)(lds + 131072 + 2560);
    conv_table_fill(wts, p->in[8] + (size_t)l * 4096, p->in[9] + l * 1024, h, tid);
    if (tid >= 320 && tid < 352) *(PG8_LAS f32x4*)(wts + 1280 + (tid - 320) * 4) = *(const f32x4*)(p->in[12] + l * 512 + h * 128 + (tid - 320) * 4);
    {
        const int lr = tid >> 2, cb = (tid & 3) * 32, tok = tok0 + lr, spos = n * 128 + lr;
        const bf16_t* cs = (const bf16_t*)(p->ws + WS_DC) + (size_t)cidx * 16384;
        u32x4 rc[4];
#pragma unroll
        for (int i = 0; i < 4; ++i) { const int q = tid + i * 512, row = q >> 4, ch = q & 15; rc[i] = *(const u32x4*)(cs + row * 128 + ch * 8); }
        u32x4 rq[4][2], rk[4][2], rv[2];
        conv_rows_load(proj, tok, spos, 1536 + h * 128 + cb, rq);
        conv_rows_load(proj, tok, spos, 2048 + h * 128 + cb, rk);
        { const bf16_t* vs = proj + (size_t)tok * PROJ_LD + 2560 + h * 128 + cb; rv[0] = *(const u32x4*)vs; rv[1] = *(const u32x4*)(vs + 8); }
        __syncthreads();
#pragma unroll
        for (int hf = 0; hf < 2; ++hf) {
            const int c0 = cb + hf * 16;
            float o[16];
            conv16_regs(rq, spos, wts, c0, o);
            u32x4 w0, w1;
            w0.x = cvt_pk_bf16(o[0], o[1]); w0.y = cvt_pk_bf16(o[2], o[3]); w0.z = cvt_pk_bf16(o[4], o[5]); w0.w = cvt_pk_bf16(o[6], o[7]);
            w1.x = cvt_pk_bf16(o[8], o[9]); w1.y = cvt_pk_bf16(o[10], o[11]); w1.z = cvt_pk_bf16(o[12], o[13]); w1.w = cvt_pk_bf16(o[14], o[15]);
            *(PG8_LAS u32x4*)(Q + swz(lr, c0 >> 3)) = w0; *(PG8_LAS u32x4*)(Q + swz(lr, (c0 >> 3) + 1)) = w1;
            conv16_regs(rk, spos, wts, 128 + c0, o);
            const float ks = 0.08838834764831845f;
            w0.x = cvt_pk_bf16(o[0] * ks, o[1] * ks); w0.y = cvt_pk_bf16(o[2] * ks, o[3] * ks); w0.z = cvt_pk_bf16(o[4] * ks, o[5] * ks); w0.w = cvt_pk_bf16(o[6] * ks, o[7] * ks);
            w1.x = cvt_pk_bf16(o[8] * ks, o[9] * ks); w1.y = cvt_pk_bf16(o[10] * ks, o[11] * ks); w1.z = cvt_pk_bf16(o[12] * ks, o[13] * ks); w1.w = cvt_pk_bf16(o[14] * ks, o[15] * ks);
            *(PG8_LAS u32x4*)(KP + swz(lr, c0 >> 3)) = w0; *(PG8_LAS u32x4*)(KP + swz(lr, (c0 >> 3) + 1)) = w1;
            const unsigned rw[8] = {rv[0].x, rv[0].y, rv[0].z, rv[0].w, rv[1].x, rv[1].y, rv[1].z, rv[1].w};
#pragma unroll
            for (int j = 0; j < 16; ++j) { const int e = c0 + j; const unsigned v16 = (j & 1) ? (rw[j >> 1] >> 16) : (rw[j >> 1] & 0xffffu);
                *(PG8_LAS bf16_t*)(VT + e * 256 + (((lr >> 3) ^ (e & 15)) << 4) + (lr & 7) * 2) = (bf16_t)v16; }
            if (hf == 0) {
                conv_rows_load(proj, tok, spos, 1536 + h * 128 + cb + 16, rq);
                conv_rows_load(proj, tok, spos, 2048 + h * 128 + cb + 16, rk);
                const bf16_t* vs = proj + (size_t)tok * PROJ_LD + 2560 + h * 128 + cb + 16; rv[0] = *(const u32x4*)vs; rv[1] = *(const u32x4*)(vs + 8);
            }
        }
#pragma unroll
        for (int i = 0; i < 4; ++i) { const int q = tid + i * 512, row = q >> 4, ch = q & 15; *(PG8_LAS u32x4*)(CT + swz(row, ch)) = rc[i]; }
    }
    __syncthreads();
    {
        const int t = tid >> 2, part = tid & 3; float s = 0.f;
#pragma unroll
        for (int i = 0; i < 4; ++i) {
            const int ch = part * 4 + i;
            const u32x4 v = *(const PG8_LAS u32x4*)(Q + swz(t, ch));
            const PG8_LAS float* nn = n0s + ch * 8;
            s += bflo(v.x) * nn[0] + bfhi(v.x) * nn[1] + bflo(v.y) * nn[2] + bfhi(v.y) * nn[3] + bflo(v.z) * nn[4] + bfhi(v.z) * nn[5] + bflo(v.w) * nn[6] + bfhi(v.w) * nn[7];
        }
        s += shx(s, 1, lane); s += shx(s, 2, lane);
        if (part == 0) dq[t] = s;
    }
    const int t = 16 * w + fr;
    const float Mt = MA[t];
    bf16_t* orow = proj + (size_t)(tok0 + t) * PROJ_LD + 512 + h * 128 + fq * 4;
    u32x2 ovp[8];
#pragma unroll
    for (int nt = 0; nt < 8; ++nt) ovp[nt] = *(const u32x2*)(orow + nt * 16);
    f32x4 acc[8];
#pragma unroll
    for (int i = 0; i < 8; ++i) acc[i] = (f32x4){0.f, 0.f, 0.f, 0.f};
    strip_mma<8>(Q, 16 * w, KP, acc, lane, 0, 4, w + 1);
    float rowsum = 0.f;
    u32x2 pk[8];
#pragma unroll
    for (int nt = 0; nt < 8; ++nt) {
        float pv[4];
#pragma unroll
        for (int j = 0; j < 4; ++j) {
            const int s = nt * 16 + fq * 4 + j;
            const float wgt = (s <= t) ? __expf(gA[s] - Mt) : 0.f;
            pv[j] = (nt <= w) ? acc[nt][j] * wgt : 0.f;
            rowsum += pv[j];
        }
        pk[nt].x = cvt_pk_bf16(pv[0], pv[1]); pk[nt].y = cvt_pk_bf16(pv[2], pv[3]);
    }
    __syncthreads();
#pragma unroll
    for (int nt = 0; nt < 8; ++nt) *(PG8_LAS u32x2*)(KP + swz(t, nt * 2 + (fq >> 1)) + (fq & 1) * 8) = pk[nt];
    f32x4 acc2[8];
#pragma unroll
    for (int i = 0; i < 8; ++i) acc2[i] = (f32x4){0.f, 0.f, 0.f, 0.f};
    strip_mma<8>(Q, 16 * w, CT, acc2, lane, 0, 4, 8);
    const float iw = __expf(m0 - Mt);
#pragma unroll
    for (int i = 0; i < 8; ++i) acc2[i] = acc2[i] * iw;
    asm volatile("s_waitcnt lgkmcnt(0)" ::: "memory");
    strip_mma<8>(KP, 16 * w, VT, acc2, lane, 0, (16 * w + 15) / 32 + 1, 8);
    rowsum += shx(rowsum, 16, lane); rowsum += shx(rowsum, 32, lane);
    const float den = iw * dq[t] + rowsum;
    const float inv = 1.0f / fmaxf(fabsf(den), __expf(-(bA[t] + Mt)));
    float ss = 0.f;
#pragma unroll
    for (int nt = 0; nt < 8; ++nt) {
        const u32x2 ov = ovp[nt];
        acc2[nt][0] = acc2[nt][0] * inv * sigmoid_f(bflo(ov.x)); acc2[nt][1] = acc2[nt][1] * inv * sigmoid_f(bfhi(ov.x));
        acc2[nt][2] = acc2[nt][2] * inv * sigmoid_f(bflo(ov.y)); acc2[nt][3] = acc2[nt][3] * inv * sigmoid_f(bfhi(ov.y));
        ss += sum4(acc2[nt] * acc2[nt]);
    }
    ss += shx(ss, 16, lane); ss += shx(ss, 32, lane);
    const float rn = rsqrtf(ss * (1.0f / 128.0f) + EPS);
    const PG8_LAS float* ng = wts + 1280 + fq * 4;
#pragma unroll
    for (int nt = 0; nt < 8; ++nt) {
        const f32x4 gv = *(const PG8_LAS f32x4*)(ng + nt * 16);
        u32x2 o; o.x = cvt_pk_bf16(acc2[nt][0] * rn * gv[0], acc2[nt][1] * rn * gv[1]); o.y = cvt_pk_bf16(acc2[nt][2] * rn * gv[2], acc2[nt][3] * rn * gv[3]);
        if (!dry) *(u32x2*)(orow + nt * 16) = o;
    }
    __syncthreads();
}

__device__ __forceinline__ void actfix_phase(KP p, int l) {
    const float* __restrict__ halo = (const float*)(p->ws + WS_HALO); bf16_t* __restrict__ act = (bf16_t*)(p->ws + WS_ACT);
    const float* cw = p->in[16] + (size_t)l * 3 * UPN; const float* cb = p->in[17] + (size_t)l * UPN;
    const int nitems = 512 * 2 * (DFF / 4);
    for (int it = obid() * 512 + otid(); it < nitems; it += gridDim.x * 512) {
        const int g = it % (DFF / 4), br = it / (DFF / 4), rr = br & 1, blk = br >> 1, ch = g * 4;
        const bool seqstart = (blk & 255) == 0;
        const f32x4 z = (f32x4){0.f, 0.f, 0.f, 0.f};
        const float* cur = halo + (size_t)(blk * 4 + rr) * UPN + ch;
        const float* pt = halo + (size_t)((blk - 1) * 4 + 2) * UPN + ch;
        const f32x4 xa = *(const f32x4*)cur, xb = *(const f32x4*)(cur + DFF);
        f32x4 p1a, p1b, p2a, p2b;
        if (rr == 0) {
            p1a = seqstart ? z : *(const f32x4*)(pt + UPN); p1b = seqstart ? z : *(const f32x4*)(pt + UPN + DFF);
            p2a = seqstart ? z : *(const f32x4*)pt;         p2b = seqstart ? z : *(const f32x4*)(pt + DFF);
        } else {
            p1a = *(const f32x4*)(cur - UPN); p1b = *(const f32x4*)(cur - UPN + DFF);
            p2a = seqstart ? z : *(const f32x4*)(pt + UPN); p2b = seqstart ? z : *(const f32x4*)(pt + UPN + DFF);
        }
        const f32x4 wa0 = *(const f32x4*)(cw + ch), wa1 = *(const f32x4*)(cw + UPN + ch), wa2 = *(const f32x4*)(cw + 2 * UPN + ch), ba = *(const f32x4*)(cb + ch);
        const f32x4 wb0 = *(const f32x4*)(cw + DFF + ch), wb1 = *(const f32x4*)(cw + UPN + DFF + ch), wb2 = *(const f32x4*)(cw + 2 * UPN + DFF + ch), bb = *(const f32x4*)(cb + DFF + ch);
        const f32x4 ca = ba + wa0 * p2a + wa1 * p1a + wa2 * xa, cbv = bb + wb0 * p2b + wb1 * p1b + wb2 * xb;
        u32x2 o; o.x = cvt_pk_bf16(silu_f(ca[0]) * cbv[0], silu_f(ca[1]) * cbv[1]); o.y = cvt_pk_bf16(silu_f(ca[2]) * cbv[2], silu_f(ca[3]) * cbv[3]);
        *(u32x2*)(act + (size_t)(blk * 64 + rr) * DFF + ch) = o;
    }
}

__device__ __forceinline__ void pconv_phase(KP p, int l) {
    const float* __restrict__ src = p->in[1] + (size_t)l * NTOK * 256; bf16_t* __restrict__ dst = (bf16_t*)(p->ws + WS_PBF);
    const int nitems = NTOK * 256 / 8, stride = gridDim.x * 512;
    for (int i0 = obid() * 512 + otid(); i0 < nitems; i0 += stride * 4) {
        f32x4 a[4], b[4];
#pragma unroll
        for (int u = 0; u < 4; ++u) { const int i = i0 + u * stride < nitems ? i0 + u * stride : i0; a[u] = *(const f32x4*)(src + (size_t)i * 8); b[u] = *(const f32x4*)(src + (size_t)i * 8 + 4); }
#pragma unroll
        for (int u = 0; u < 4; ++u) { const int i = i0 + u * stride;
            if (i < nitems) { u32x4 wv; wv.x = cvt_pk_bf16(a[u][0], a[u][1]); wv.y = cvt_pk_bf16(a[u][2], a[u][3]); wv.z = cvt_pk_bf16(b[u][0], b[u][1]); wv.w = cvt_pk_bf16(b[u][2], b[u][3]); *(u32x4*)(dst + (size_t)i * 8) = wv; } }
    }
}

__device__ __forceinline__ void final_phase(KP p, const float* ssq) {
    const int tid = otid(), lane = tid & 63, w = __builtin_amdgcn_readfirstlane(tid >> 6);
    f32x4 g[4];
#pragma unroll
    for (int i = 0; i < 4; ++i) g[i] = *(const f32x4*)(p->in[22] + i * 256 + lane * 4);
    for (int rowb = obid() * 8 + w; rowb < NTOK; rowb += gridDim.x * 8 * 4) {
        const int rstep = gridDim.x * 8;
        f32x4 xv[4][4]; float rr[4];
#pragma unroll
        for (int u = 0; u < 4; ++u) { const int row = rowb + u * rstep < NTOK ? rowb + u * rstep : rowb; rr[u] = rowscale(ssq, row);
#pragma unroll
            for (int i = 0; i < 4; ++i) xv[u][i] = *(const f32x4*)(p->out + (size_t)row * DM + i * 256 + lane * 4); }
#pragma unroll
        for (int u = 0; u < 4; ++u) { const int row = rowb + u * rstep;
            if (row < NTOK) {
#pragma unroll
                for (int i = 0; i < 4; ++i) *(f32x4*)(p->out + (size_t)row * DM + i * 256 + lane * 4) = xv[u][i] * rr[u] * g[i];
            } }
    }
}

#ifndef PROBE_STAGE
#define PROBE_STAGE 0
#endif
__device__ __forceinline__ void dump_phase(KP p) {
    const bf16_t* proj = (const bf16_t*)(p->ws + WS_PROJ); const float* gates = (const float*)(p->ws + WS_GATES); const float* lnstat = (const float*)(p->ws + WS_LNSTAT);
    const bf16_t* dc = (const bf16_t*)(p->ws + WS_DC); const float* dn = (const float*)(p->ws + WS_DN); const float* chs = (const float*)(p->ws + WS_CHBL);
    for (int i = obid() * 512 + otid(); i < NTOK * DM; i += gridDim.x * 512) {
        const int row = i >> 10, c = i & 1023;
        float v = bf2f(proj[(size_t)row * PROJ_LD + c]) + bf2f(proj[(size_t)row * PROJ_LD + 1024 + c]) + bf2f(proj[(size_t)row * PROJ_LD + 2048 + c]) + gates[(size_t)row * 8 + (c & 7)] + lnstat[(size_t)row * 16 + (c & 15)];
        if (PROBE_STAGE >= 2) v += bf2f(dc[i & (8 * 128 * 16384 - 1)]) + dn[i & 131071] + chs[i & 2047];
        if (PROBE_STAGE >= 3) v += chs[2048 + (i & 1023)];
        p->out[i] = v;
    }
}
#define PROBE_AT(s) do { if (PROBE_STAGE == (s)) { if ((s) <= 4) dump_phase(p); return; } } while (0)
#define XB_TMO      128
#define XB_XCNT(j)  (256  + 64 * (j))
#define XB_XSUB(j)  (1280 + 64 * (j))
#define XB_XGEN(j)  (2304 + 64 * (j))
#define XB_TOP      3328
#define XB_TOPGEN   3392
#define XCD_BAR_WORDS 3456
#define XB_SPIN_CAP (1u << 18)

__device__ __forceinline__ unsigned xb_ld(unsigned* p)              { return __hip_atomic_load(p, __ATOMIC_RELAXED, __HIP_MEMORY_SCOPE_AGENT); }
__device__ __forceinline__ unsigned xb_add(unsigned* p, unsigned v) { return __hip_atomic_fetch_add(p, v, __ATOMIC_RELAXED, __HIP_MEMORY_SCOPE_AGENT); }
__device__ __forceinline__ unsigned xb_xcc_id() { return (unsigned)__builtin_amdgcn_s_getreg((3 << 11) | 20) & 0xFu; }
#define XB_SPIN(cond, bar) do { unsigned _sp = 0; while (cond) { __builtin_amdgcn_s_sleep(1); \
    if ((++_sp & 255u) == 0u) { if (xb_ld(&(bar)[XB_TMO])) break; if (_sp > XB_SPIN_CAP) { atomicAdd(&(bar)[XB_TMO], 1u); break; } } } } while (0)

struct XcdBarrier {
    unsigned* bar; unsigned x;
    volatile PG8_LAS unsigned* st;
};

__device__ __forceinline__ XcdBarrier xcd_barrier_post(unsigned* bar, volatile PG8_LAS unsigned* st) {
    XcdBarrier b; b.bar = bar; b.x = xb_xcc_id(); b.st = st;
    if (otid() == 0) (void)xb_add(&bar[XB_XCNT(b.x)], 1u);
    return b;
}
__device__ __forceinline__ void xcd_barrier_complete(unsigned* bar, unsigned x, unsigned& nloc, unsigned& nx) {
    const unsigned G = gridDim.x * gridDim.y * gridDim.z;
    unsigned sum, cnt, mine, sp = 0u;
    for (;;) {
        sum = 0u; cnt = 0u; mine = 0u;
#pragma unroll
        for (unsigned j = 0; j < 16; ++j) { const unsigned c = xb_ld(&bar[XB_XCNT(j)]); sum += c; cnt += (c > 0u) ? 1u : 0u; mine = (j == x) ? c : mine; }
        if (sum == G) break;
        __builtin_amdgcn_s_sleep(1);
        if ((++sp & 255u) == 0u) { if (xb_ld(&bar[XB_TMO])) break; if (sp > XB_SPIN_CAP) { atomicAdd(&bar[XB_TMO], 1u); break; } }
    }
    nloc = mine > 0u ? mine : 1u; nx = cnt > 0u ? cnt : 1u;
}

__device__ __forceinline__ void xcd_barrier(const XcdBarrier& b) {
    asm volatile("s_waitcnt vmcnt(0)" ::: "memory");
    __syncthreads();
    if (otid() == 0) {
        unsigned* bar = b.bar;
        __builtin_amdgcn_s_waitcnt(0);
        unsigned nloc = b.st[0], nx = b.st[1];
        if (nloc == 0u) { xcd_barrier_complete(bar, b.x, nloc, nx); b.st[0] = nloc; b.st[1] = nx; }
        const unsigned old = xb_add(&bar[XB_XSUB(b.x)], 1u);
        const unsigned gen = old / nloc;
        if (old + 1u == (gen + 1u) * nloc) {
            __builtin_amdgcn_fence(__ATOMIC_RELEASE, "agent");
            asm volatile("s_waitcnt vmcnt(0)" ::: "memory");
            const unsigned og = xb_add(&bar[XB_TOP], 1u);
            const unsigned tg = og / nx;
            if (og + 1u == (tg + 1u) * nx) xb_add(&bar[XB_TOPGEN], 1u);
            else XB_SPIN(xb_ld(&bar[XB_TOPGEN]) == tg, bar);
            __builtin_amdgcn_fence(__ATOMIC_ACQUIRE, "agent");
            xb_add(&bar[XB_XGEN(b.x)], 1u);
            asm volatile("s_waitcnt vmcnt(0)" ::: "memory");
        } else {
            XB_SPIN(xb_ld(&bar[XB_XGEN(b.x)]) == gen, bar);
            __builtin_amdgcn_fence(__ATOMIC_ACQUIRE, "agent");
            asm volatile("s_waitcnt vmcnt(0)" ::: "memory");
        }
    }
    __syncthreads();
}


#define GSYNC() do { asm volatile("s_waitcnt vmcnt(0)" ::: "memory"); grid.sync(); } while (0)
#define XSYNC() do { XcdBarrier t_; t_.bar = (unsigned*)(p->ws + WS_BAR); t_.x = xb_x; t_.st = xst; asm volatile("" : "+s"(t_.x)); xcd_barrier(t_); } while (0)
__global__ void __launch_bounds__(512, 2) fwd_kernel(Params p_arg) {
    KP kp0 = (KP)__builtin_amdgcn_kernarg_segment_ptr(); (void)p_arg;
#define p okp(kp0)
    extern __shared__ __attribute__((aligned(16))) unsigned char shm[];
    ldsp lds = (ldsp)shm;
    cg::grid_group grid = cg::this_grid();
    unsigned char* ws = p->ws;
    volatile PG8_LAS unsigned* xst = (volatile PG8_LAS unsigned*)(lds + 131072 + 1024 + 8192);
    if (threadIdx.x < 4) xst[threadIdx.x] = 0u;
    __syncthreads();
    const unsigned xb_x = __builtin_amdgcn_readfirstlane(xcd_barrier_post((unsigned*)(ws + WS_BAR), xst).x);
    prep_phase(lds, p);
#ifdef REP_PREP
    prep_phase(lds, p);
#endif
    if (p->ws == nullptr) GSYNC();
    XSYNC();
    int cur = 0;
#pragma unroll 1
    for (int l = 0; l < DEPTH; ++l) {
        bf16_t* xb_c = (bf16_t*)(ws + (cur ? WS_XB1 : WS_XB0)); bf16_t* xb_n = (bf16_t*)(ws + (cur ? WS_XB0 : WS_XB1));
        float* ssq_c = (float*)(ws + (cur ? WS_SSQ1 : WS_SSQ0)); float* ssq_n = (float*)(ws + (cur ? WS_SSQ0 : WS_SSQ1));
        const unsigned char* wt = ws + WS_WT + (size_t)l * WT_LAYER;
        bf16_t* proj = (bf16_t*)(ws + WS_PROJ);
#ifdef REP_A
        gates_phase(lds, p, l, xb_c, ssq_c, 2);
        { EpiProj E; E.rl = (PG8_LAS float*)(lds + 131072); E.proj = proj; E.ssq = ssq_c; E.lnstat = (float*)(ws + WS_LNSTAT); run_gemm(lds, xb_c, DM, (const bf16_t*)(wt + WT_IN), NTOK, 3072, 1024, E); }
#endif
        if (obid() & 1) gates_phase(lds, p, l, xb_c, ssq_c, 2);
        { EpiProj E; E.rl = (PG8_LAS float*)(lds + 131072); E.proj = proj; E.ssq = ssq_c; E.lnstat = (float*)(ws + WS_LNSTAT); run_gemm(lds, xb_c, DM, (const bf16_t*)(wt + WT_IN), NTOK, 3072, 1024, E); }
        if (!(obid() & 1)) gates_phase(lds, p, l, xb_c, ssq_c, 2);
        XSYNC();
        PROBE_AT(1);
#ifdef REP_GM
        for (int t = obid(); t < 2048; t += gridDim.x) gmlp_task(lds, p, l, t, true);
#endif
#ifdef REP_DC
        for (int t = obid(); t < 1024; t += gridDim.x) mlstm_dc_task(lds, p, l, t);
#endif
#ifdef REP_SYNC
        for (int q = 0; q < 10; ++q) XSYNC();
#endif
        for (int t = obid(); t < 3072; t += gridDim.x) {
#if !defined(PROBE_B_ONLY) || PROBE_B_ONLY == 1
            if (t < 1024) mlstm_dc_task(lds, p, l, t);
#endif
#if !defined(PROBE_B_ONLY) || PROBE_B_ONLY == 2
            if (t >= 1024) gmlp_task(lds, p, l, t - 1024);
#endif
        }
        XSYNC();
        PROBE_AT(2);
#ifdef REP_C
        scan_phase(p, true);
#endif
        scan_phase(p);
        XSYNC();
        PROBE_AT(3);
#ifdef REP_D
        for (int t = obid(); t < 1024; t += gridDim.x) mlstm_out_task(lds, p, l, t, true);
#endif
        for (int t = obid(); t < 1024; t += gridDim.x) mlstm_out_task(lds, p, l, t);
        XSYNC();
        PROBE_AT(4);
#ifdef REP_E0
        if (l == 0) { EpiResid E; E.dry = 0; E.xin = p->in[0]; E.xout = p->out; E.xb = xb_n; E.ssq = ssq_n; E.row_off = 0; run_gemm(lds, proj, PROJ_LD, (const bf16_t*)(wt + WT_OUT), NTOK, 1024, 1024, E); }
#endif
        { EpiResid E; E.dry = 0; E.xin = l == 0 ? p->in[0] : p->out; E.xout = p->out; E.xb = xb_n; E.ssq = ssq_n; E.row_off = 0; run_gemm(lds, proj, PROJ_LD, (const bf16_t*)(wt + WT_OUT), NTOK, 1024, 1024, E); }
        XSYNC();
        PROBE_AT(5);
        { EpiUpAct E; E.rl = (PG8_LAS float*)(lds + 131072); E.act = (bf16_t*)(ws + WS_ACT); E.halo = (float*)(ws + WS_HALO); E.ssq = ssq_n; E.cw = p->in[16] + (size_t)l * 3 * UPN; E.cb = p->in[17] + (size_t)l * UPN;
          run_gemm(lds, xb_n, DM, (const bf16_t*)(wt + WT_UP), NTOK, UPN, 1024, E);
#ifdef REP_F
          run_gemm(lds, xb_n, DM, (const bf16_t*)(wt + WT_UP), NTOK, UPN, 1024, E);
#endif
        }
        XSYNC();
#ifdef REP_G
        actfix_phase(p, l);
#endif
        actfix_phase(p, l);
        XSYNC();
#ifdef REP_PCONV
        pconv_phase(p, l);
#endif
#ifdef REP_H
        { EpiResid E; E.dry = 1; E.xin = p->out; E.xout = p->out; E.xb = xb_c; E.ssq = ssq_c; E.row_off = 0; run_gemm(lds, (const bf16_t*)(ws + WS_ACT), DFF, (const bf16_t*)(wt + WT_DOWN), NTOK, 1024, DFF, E); }
#endif
        if (obid() & 1) pconv_phase(p, l);
        { EpiResid E; E.dry = 0; E.xin = p->out; E.xout = p->out; E.xb = xb_c; E.ssq = ssq_c; E.row_off = 0; run_gemm(lds, (const bf16_t*)(ws + WS_ACT), DFF, (const bf16_t*)(wt + WT_DOWN), NTOK, 1024, DFF, E); }
        if (!(obid() & 1)) pconv_phase(p, l);
        XSYNC();
        PROBE_AT(6);
#ifdef REP_PE
        { EpiPe E; E.pe = (bf16_t*)(ws + WS_PE); run_gemm(lds, (const bf16_t*)(ws + WS_PBF), 256, (const bf16_t*)(wt + WT_PLE), NTOK, 1024, 256, E); }
#endif
        { EpiPe E; E.pe = (bf16_t*)(ws + WS_PE); run_gemm(lds, (const bf16_t*)(ws + WS_PBF), 256, (const bf16_t*)(wt + WT_PLE), NTOK, 1024, 256, E); }
#ifdef REP_GATE
        { EpiGate E; E.dry = 1; E.rl = (PG8_LAS float*)(lds + 131072); E.x = p->out; E.pe = (const bf16_t*)(ws + WS_PE); E.ssq_in = ssq_c; E.xb = xb_n; E.ssq = ssq_n; run_gemm(lds, xb_c, DM, (const bf16_t*)(wt + WT_GATE), NTOK, 1024, 1024, E); }
#endif
        { EpiGate E; E.dry = 0; E.rl = (PG8_LAS float*)(lds + 131072); E.x = p->out; E.pe = (const bf16_t*)(ws + WS_PE); E.ssq_in = ssq_c; E.xb = xb_n; E.ssq = ssq_n; run_gemm(lds, xb_c, DM, (const bf16_t*)(wt + WT_GATE), NTOK, 1024, 1024, E); }
        XSYNC();
        PROBE_AT(7);
        cur ^= 1;
    }
    final_phase(p, (const float*)(ws + (cur ? WS_SSQ1 : WS_SSQ0)));
}

#undef p
extern "C" void kernel_launch(void* const* d_in, const int* in_sizes, int n_in, void* d_out, int out_size, void* d_ws, size_t ws_size, hipStream_t stream) {
    static int grid_blocks = 0;
    if (grid_blocks == 0) {
        if (n_in != 23 || ws_size < WS_END) { fprintf(stderr, "kernel_launch: unexpected n_in %d / ws_size %zu (need %zu)\n", n_in, ws_size, (size_t)WS_END); grid_blocks = -1; return; }
        int dev = 0, cus = 0, per_cu = 0;
        hipGetDevice(&dev);
        hipDeviceGetAttribute(&cus, hipDeviceAttributeMultiprocessorCount, dev);
        if (hipFuncSetAttribute((const void*)fwd_kernel, hipFuncAttributeMaxDynamicSharedMemorySize, LDS_BYTES) != hipSuccess) { fprintf(stderr, "kernel_launch: hipFuncSetAttribute failed\n"); grid_blocks = -1; return; }
        if (hipOccupancyMaxActiveBlocksPerMultiprocessor(&per_cu, (const void*)fwd_kernel, 512, LDS_BYTES) != hipSuccess || per_cu < 1) { fprintf(stderr, "kernel_launch: occupancy query failed (%d)\n", per_cu); per_cu = 1; (void)hipGetLastError(); }
        grid_blocks = cus * per_cu;
        if (grid_blocks > 256) grid_blocks = 256;
    }
    if (grid_blocks < 0) return;
    if (hipMemsetAsync((char*)d_ws + WS_BAR, 0, XCD_BAR_WORDS * sizeof(unsigned), stream) != hipSuccess) { fprintf(stderr, "kernel_launch: memset of the barrier words failed\n"); return; }
    Params p{};
    for (int i = 0; i < 23; ++i) p.in[i] = (const float*)d_in[i];
    p.out = (float*)d_out; p.ws = (unsigned char*)d_ws;
    void* args[] = {&p};
    hipError_t e = hipLaunchCooperativeKernel((const void*)fwd_kernel, dim3(grid_blocks), dim3(512), args, LDS_BYTES, stream);
    if (e != hipSuccess) fprintf(stderr, "cooperative launch failed: %s (grid %d)\n", hipGetErrorString(e), grid_blocks);
}
```

```cpp
#include <hip/hip_runtime.h>
#include <hip/hip_cooperative_groups.h>
#include <cstdio>
namespace cg = cooperative_groups;
namespace pg8 {
#define PG8_LAS __attribute__((address_space(3)))
typedef unsigned short bf16_t;
typedef short bf16x8 __attribute__((ext_vector_type(8)));
typedef float f32x4 __attribute__((ext_vector_type(4)));
typedef unsigned u32x4 __attribute__((ext_vector_type(4)));
constexpr int BM = 256, BK = 64, HALF = 128, HTB = HALF * BK * 2  , STAGE_BYTES = 8 * HTB, NXCD = 8, WGM = 8;

__host__ __device__ __forceinline__ int lds_byte(int r, int c) { const int st = (r >> 4) * 2 + (c >> 5), rr = r & 15, cc = c & 31, ob = rr * 64 + cc * 2; return st * 1024 + (ob ^ (((ob >> 9) & 1) << 5)); }
__host__ __device__ __forceinline__ void stage_rc(int b, int& R, int& C) { const int st = b / 1024, sb = b % 1024, swz = sb ^ (((sb >> 9) & 1) << 5); R = (st >> 1) * 16 + swz / 64; C = (st & 1) * 32 + (swz % 64) / 2; }
__host__ __device__ __forceinline__ int perm32(int rho) { const int n = rho >> 4, i = rho & 15; return 8 * (i >> 2) + 4 * n + (i & 3); }
__device__ __forceinline__ int otid() { int t = (int)threadIdx.x; asm volatile("" : "+v"(t)); return t; }
__device__ __forceinline__ int obid() { int t = (int)blockIdx.x; asm volatile("" : "+s"(t)); return t; }
struct Unit { int pm, pn; };
struct Gemm { const bf16_t* A; const bf16_t* Bt; int M, N, K, lda; };

struct StaticOrder {
    int nM, nN, nwg, G, c;
    __host__ __device__ void init(int M, int N, int G_, int c_) { nM = M / BM; nN = N / BM; nwg = nM * nN; G = G_; c = c_; }
    __host__ __device__ bool next(int i, Unit& u) const {
        const long L = (long)i * G + c; if (L >= nwg) return false;
        int wgid = (int)L; { const int q = nwg / NXCD, r = nwg % NXCD, xcd = wgid % NXCD, off = wgid / NXCD; wgid = (xcd < r ? xcd * (q + 1) : r * (q + 1) + (xcd - r) * q) + off; }
        const int nig = WGM * nN, gid = wgid / nig, fm = gid * WGM, gsz = (nM - fm) < WGM ? (nM - fm) : WGM;
        u.pm = fm + ((wgid % nig) % gsz); u.pn = (wgid % nig) / gsz; return true;
    }
    __device__ __forceinline__ void a_ready(const Unit&) const {}
    __device__ __forceinline__ void done(const Unit&) const {}
};
__device__ __forceinline__ unsigned cvt_pk_bf16(float lo, float hi) { typedef __bf16 bf2_t __attribute__((ext_vector_type(2))); typedef float f2_t __attribute__((ext_vector_type(2))); const bf2_t r = __builtin_convertvector((f2_t){lo, hi}, bf2_t); return __builtin_bit_cast(unsigned, r); }
typedef float f32x2 __attribute__((ext_vector_type(2)));
__device__ __forceinline__ f32x2 gelu_pk(f32x2 v) {
    const f32x2 av = __builtin_elementwise_abs(v), d = av * 0.2316418882f + 1.0f;
    f32x2 t; t.x = __builtin_amdgcn_rcpf(d.x); t.y = __builtin_amdgcn_rcpf(d.y);
    f32x2 q = t * 0.5307027145f + (-0.7265760135f); q = q * t + 0.7107068705f; q = q * t + (-0.142248368f); q = q * t + 0.127414796f; q = q * t;
    const f32x2 s = (v * v) * (-0.72134752044f);
    f32x2 e; e.x = __builtin_amdgcn_exp2f(s.x); e.y = __builtin_amdgcn_exp2f(s.y);
    const f32x2 m = v * (q * e), r = v - m;
    f32x2 o; o.x = v.x < 0.f ? m.x : r.x; o.y = v.y < 0.f ? m.y : r.y; return o;
}

template <class Epi, class Sched>
__device__ __forceinline__ void gemm_phase(PG8_LAS unsigned char* lds, const Gemm g, const Sched& S, const Epi& E) {
    const int tid = otid(), wid = __builtin_amdgcn_readfirstlane(tid >> 6), lane = tid & 63, wr = wid >> 2, wc = wid & 3, fr = lane & 15, fq = lane >> 4;
    const int K = g.K, nt = K / BK;
    unsigned voffA[2], voffB[2];
#pragma unroll
    for (int i = 0; i < 2; ++i) { int R, C; stage_rc(tid * 16 + i * 8192, R, C); const int Rb = Epi::PERM ? ((R & ~31) + perm32(R & 31)) : R;
        const int Ra = Epi::APERM ? ((R & ~63) + 4 * (R & 15) + ((R >> 4) & 3)) : R;
        voffA[i] = (unsigned)(Ra * g.lda + C) * 2u; voffB[i] = (unsigned)(Rb * K + C) * 2u; }
    const size_t kstep = (size_t)(BK * 2);
    const size_t hstepB = (size_t)HALF * K * 2, hstepA = (size_t)HALF * g.lda * 2;
    const size_t tstepB = 2 * hstepB, tstepA = 2 * hstepA;
    const unsigned ldsw = (unsigned)wid * 1024u;
    const int aoff = lds_byte(wr * 64 + fr, fq * 8), boff = lds_byte(wc * 32 + fr, fq * 8);
#define PG8_SA(b, h) (((b) * 2 + (h)) * HTB)
#define PG8_SB(b, h) ((4 + (b) * 2 + (h)) * HTB)
#define PG8_STAGE(bufoff, gbase, voff) do { _Pragma("unroll") for (int _i = 0; _i < 2; ++_i) \
        __builtin_amdgcn_global_load_lds((const unsigned*)((const char*)(gbase) + (voff)[_i]), (PG8_LAS unsigned*)(lds + (bufoff) + ldsw + _i * 8192), 16, 0, 0); } while (0)
#define PG8_LDA(dst, b, h) do { _Pragma("unroll") for (int m = 0; m < 4; ++m) _Pragma("unroll") for (int k = 0; k < 2; ++k) dst[m][k] = *(const PG8_LAS bf16x8*)(lds + PG8_SA(b, h) + aoff + m * 2048 + k * 1024); } while (0)
#define PG8_LDB(dst, b, h) do { _Pragma("unroll") for (int n = 0; n < 2; ++n) _Pragma("unroll") for (int k = 0; k < 2; ++k) dst[n][k] = *(const PG8_LAS bf16x8*)(lds + PG8_SB(b, h) + boff + n * 2048 + k * 1024); } while (0)
#define PG8_MMA(ai, bj, At, Bt) do { __builtin_amdgcn_s_setprio(1); _Pragma("unroll") for (int m = 0; m < 4; ++m) _Pragma("unroll") for (int n = 0; n < 2; ++n) _Pragma("unroll") for (int k = 0; k < 2; ++k) \
        acc[ai][bj][m][n] = __builtin_amdgcn_mfma_f32_16x16x32_bf16(Bt[n][k], At[m][k], acc[ai][bj][m][n], 0, 0, 0); __builtin_amdgcn_s_setprio(0); } while (0)
#define PG8_WAIT_V(n) asm volatile("s_waitcnt vmcnt(" #n ")" ::: "memory")
#define PG8_WAIT_L(n) asm volatile("s_waitcnt lgkmcnt(" #n ")" ::: "memory")
#define PG8_BAR __builtin_amdgcn_s_barrier()
#define PG8_SCHED __builtin_amdgcn_sched_barrier(0)
    Unit cur, nxt; int ui = 0;
    if (!S.next(0, cur)) return;
    f32x4 acc[2][2][4][2];
#pragma unroll
    for (int a = 0; a < 2; ++a)
#pragma unroll
        for (int b = 0; b < 2; ++b)
#pragma unroll
            for (int m = 0; m < 4; ++m)
#pragma unroll
                for (int n = 0; n < 2; ++n) acc[a][b][m][n] = (f32x4){0.f, 0.f, 0.f, 0.f};
    bf16x8 At[4][2], B0[2][2], B1[2][2];
    const char* cA = (const char*)g.A + (size_t)cur.pm * tstepA; const char* cB = (const char*)g.Bt + (size_t)cur.pn * tstepB;
    S.a_ready(cur);
    PG8_STAGE(PG8_SB(0, 0), cB, voffB); PG8_STAGE(PG8_SA(0, 0), cA, voffA); PG8_STAGE(PG8_SB(0, 1), cB + hstepB, voffB); PG8_STAGE(PG8_SA(0, 1), cA + hstepA, voffA);
    if (wr == 1) PG8_BAR;
    PG8_WAIT_V(4); PG8_BAR;
    PG8_STAGE(PG8_SB(1, 0), cB + kstep, voffB); PG8_STAGE(PG8_SA(1, 0), cA + kstep, voffA); PG8_STAGE(PG8_SB(1, 1), cB + hstepB + kstep, voffB);
    PG8_WAIT_V(6); PG8_BAR;
    for (;;) {
        const bool has_next = S.next(ui + 1, nxt);
        const char* nA = has_next ? (const char*)g.A + (size_t)nxt.pm * tstepA : cA; const char* nB = has_next ? (const char*)g.Bt + (size_t)nxt.pn * tstepB : cB;
        for (int t = 0; t < nt; t += 2) {
            const bool last = (t == nt - 2);
            const char* a1 = cA + (size_t)(t + 1) * kstep;
            const char* a2 = last ? nA : cA + (size_t)(t + 2) * kstep; const char* b2 = last ? nB : cB + (size_t)(t + 2) * kstep;
            const char* a3 = a2 + kstep; const char* b3 = b2 + kstep;
            if (last && has_next) S.a_ready(nxt);
            PG8_LDB(B0, 0, 0); PG8_SCHED; PG8_LDA(At, 0, 0); PG8_STAGE(PG8_SA(1, 1), a1 + hstepA, voffA);
            PG8_WAIT_L(8); PG8_BAR; PG8_WAIT_L(0); PG8_MMA(0, 0, At, B0); PG8_BAR; PG8_SCHED;
            PG8_LDB(B1, 0, 1); PG8_STAGE(PG8_SB(0, 0), b2, voffB);
            PG8_BAR; PG8_WAIT_L(0); PG8_MMA(0, 1, At, B1); PG8_BAR;
            PG8_LDA(At, 0, 1); PG8_STAGE(PG8_SA(0, 0), a2, voffA);
            PG8_BAR; PG8_WAIT_L(0); PG8_MMA(1, 0, At, B0); PG8_BAR; PG8_SCHED;
            PG8_STAGE(PG8_SB(0, 1), b2 + hstepB, voffB);
            PG8_WAIT_V(6); PG8_BAR; PG8_MMA(1, 1, At, B1); PG8_BAR;
            PG8_LDB(B0, 1, 0); PG8_SCHED; PG8_LDA(At, 1, 0); PG8_STAGE(PG8_SA(0, 1), a2 + hstepA, voffA);
            PG8_WAIT_L(8); PG8_BAR; PG8_WAIT_L(0); PG8_MMA(0, 0, At, B0); PG8_BAR; PG8_SCHED;
            PG8_LDB(B1, 1, 1); PG8_STAGE(PG8_SB(1, 0), b3, voffB);
            PG8_BAR; PG8_WAIT_L(0); PG8_MMA(0, 1, At, B1); PG8_BAR;
            PG8_LDA(At, 1, 1); PG8_STAGE(PG8_SA(1, 0), a3, voffA);
            PG8_BAR; PG8_WAIT_L(0); PG8_MMA(1, 0, At, B0); PG8_BAR; PG8_SCHED;
            PG8_STAGE(PG8_SB(1, 1), b3 + hstepB, voffB);
            PG8_WAIT_V(6); PG8_BAR; PG8_MMA(1, 1, At, B1); PG8_BAR;
        }
        if constexpr (!Epi::AFTER_DRAIN) { E(acc, cur, wr, wc, fr, fq); S.done(cur); }
        if (!has_next) break;
#pragma unroll
        for (int a = 0; a < 2; ++a)
#pragma unroll
            for (int b = 0; b < 2; ++b)
#pragma unroll
                for (int m = 0; m < 4; ++m)
#pragma unroll
                    for (int n = 0; n < 2; ++n) acc[a][b][m][n] = (f32x4){0.f, 0.f, 0.f, 0.f};
        cur = nxt; cA = nA; cB = nB; ++ui;
    }
    PG8_WAIT_V(0);
    if (wr == 0) PG8_BAR;
    PG8_BAR;
    if constexpr (Epi::AFTER_DRAIN) { E.fused(acc, cur, wr, wc, fr, fq, lds, wid, lane); S.done(cur); }
#undef PG8_SA
#undef PG8_SB
#undef PG8_STAGE
#undef PG8_LDA
#undef PG8_LDB
#undef PG8_MMA
#undef PG8_WAIT_V
#undef PG8_WAIT_L
#undef PG8_BAR
#undef PG8_SCHED
}
}

using pg8::otid; using pg8::obid; using pg8::bf16_t; using pg8::bf16x8; using pg8::f32x4; using pg8::u32x4; using pg8::f32x2; using pg8::cvt_pk_bf16; using pg8::gelu_pk;
typedef unsigned u32x2 __attribute__((ext_vector_type(2)));
typedef PG8_LAS unsigned char* ldsp;

constexpr int NTOK = 32768, SEQ = 16384, DM = 1024, DEPTH = 4, PROJ_LD = 3072, DFF = 2816, UPN = 5632;
constexpr float EPS = 1e-6f;
constexpr int LDS_BYTES = 131072 + 1024 + 8192 + 16;
constexpr size_t MiB = 1ull << 20;
constexpr size_t WS_XB0 = 0, WS_XB1 = 64 * MiB, WS_WT = 128 * MiB;
constexpr size_t WT_IN = 0, WT_OUT = 6291456, WT_UP = 8388608, WT_DOWN = 19922944, WT_GATE = 25690112, WT_PLE = 27787264, WT_WSB = 28311552, WT_LAYER = 28573696;
constexpr size_t WS_SMALL = 237 * MiB;
constexpr size_t WS_SSQ0 = WS_SMALL, WS_SSQ1 = WS_SMALL + 2 * MiB, WS_LNSTAT = WS_SMALL + 4 * MiB, WS_GATES = WS_SMALL + 6 * MiB, WS_DN = WS_SMALL + 7 * MiB;
constexpr size_t WS_CHBL = WS_SMALL + 7 * MiB + 512 * 1024, WS_CHAMAX = WS_CHBL + 4096, WS_CHM0 = WS_CHBL + 8192, WS_WG = WS_CHBL + 65536, WS_BAR = WS_CHBL + 65536 + 131072;
constexpr size_t WS_R = 245 * MiB;
constexpr size_t WS_PROJ = WS_R, WS_DC = WS_R + 192 * MiB, WS_ACT = WS_R, WS_HALO = WS_R + 176 * MiB, WS_PBF = WS_R + 176 * MiB, WS_PE = WS_R;
constexpr size_t WS_END = WS_R + 264 * MiB;

struct Params { const float* in[23]; float* out; unsigned char* ws; };
typedef const Params __attribute__((address_space(4)))* KP;
__device__ __forceinline__ KP okp(KP p) { asm volatile("" : "+s"(p)); return p; }

__device__ __forceinline__ float bflo(unsigned w) { return __uint_as_float(w << 16); }
__device__ __forceinline__ float bfhi(unsigned w) { return __uint_as_float(w & 0xffff0000u); }
__device__ __forceinline__ bf16_t f2bf(float f) { return (bf16_t)(cvt_pk_bf16(f, 0.f) & 0xffffu); }
__device__ __forceinline__ float bf2f(bf16_t b) { return __uint_as_float(((unsigned)b) << 16); }
__device__ __forceinline__ float sigmoid_f(float x) { return __builtin_amdgcn_rcpf(1.f + __builtin_amdgcn_exp2f(x * -1.4426950408889634f)); }
__device__ __forceinline__ float silu_f(float x) { return x * __builtin_amdgcn_rcpf(1.f + __builtin_amdgcn_exp2f(x * -1.4426950408889634f)); }
__device__ __forceinline__ float shx(float v, int mask, int lane) { return __builtin_bit_cast(float, __builtin_amdgcn_ds_bpermute((lane ^ mask) << 2, __builtin_bit_cast(int, v))); }
__device__ __forceinline__ float shup(float v, int d, int lane) { return __builtin_bit_cast(float, __builtin_amdgcn_ds_bpermute((lane - d) << 2, __builtin_bit_cast(int, v))); }
__device__ __forceinline__ float wave_sum(float v, int lane) {
#pragma unroll
    for (int o = 32; o >= 1; o >>= 1) v += shx(v, o, lane);
    return v;
}
__device__ __forceinline__ float wave_max(float v, int lane) {
#pragma unroll
    for (int o = 32; o >= 1; o >>= 1) v = fmaxf(v, shx(v, o, lane));
    return v;
}
#define DPP_F(old, v, ctrl, rmask) __builtin_bit_cast(float, __builtin_amdgcn_update_dpp(__builtin_bit_cast(int, (float)(old)), __builtin_bit_cast(int, (float)(v)), ctrl, rmask, 0xf, false))
__device__ __forceinline__ float wave_incl_sum(float v, int lane) {
    (void)lane;
    v += DPP_F(0.f, v, 0x111, 0xf); v += DPP_F(0.f, v, 0x112, 0xf); v += DPP_F(0.f, v, 0x114, 0xf); v += DPP_F(0.f, v, 0x118, 0xf);
    v += DPP_F(0.f, v, 0x142, 0xa);
    v += DPP_F(0.f, v, 0x143, 0xc);
    return v;
}
__device__ __forceinline__ float wave_incl_max(float v, int lane) {
    (void)lane;
    const float ninf = -INFINITY;
    v = fmaxf(v, DPP_F(ninf, v, 0x111, 0xf)); v = fmaxf(v, DPP_F(ninf, v, 0x112, 0xf)); v = fmaxf(v, DPP_F(ninf, v, 0x114, 0xf)); v = fmaxf(v, DPP_F(ninf, v, 0x118, 0xf));
    v = fmaxf(v, DPP_F(ninf, v, 0x142, 0xa));
    v = fmaxf(v, DPP_F(ninf, v, 0x143, 0xc));
    return v;
}
__device__ __forceinline__ float sum4(f32x4 a) { return (a[0] + a[1]) + (a[2] + a[3]); }
__device__ __forceinline__ float rowscale(const float* ssq, int row) {
    const float* s = ssq + (size_t)row * 16;
    const f32x4 a = *(const f32x4*)s, b = *(const f32x4*)(s + 4), c = *(const f32x4*)(s + 8), d = *(const f32x4*)(s + 12);
    const float t = (sum4(a) + sum4(b)) + (sum4(c) + sum4(d));
    return rsqrtf(t * (1.0f / 1024.0f) + EPS);
}
__device__ __forceinline__ int swz(int row, int ch) { return row * 256 + ((ch ^ (row & 15)) << 4); }

__device__ __forceinline__ void rtable_build(const float* ssq, int row_base, int wr, int wc, int fr, int fq, PG8_LAS float* rl) {
    const int lane = fq * 16 + fr, t = wc * 64 + lane, idx = t >> 1, hsel = t & 1;
    const int lrow = (idx >> 6) * 128 + wr * 64 + (idx & 63);
    const float* s = ssq + (size_t)(row_base + lrow) * 16 + hsel * 8;
    const f32x4 a = *(const f32x4*)s, b = *(const f32x4*)(s + 4);
    float v = sum4(a) + sum4(b);
    v += shx(v, 1, lane);
    if (hsel == 0) rl[lrow] = rsqrtf(v * (1.0f / 1024.0f) + EPS);
    asm volatile("s_waitcnt lgkmcnt(0)" ::: "memory"); __builtin_amdgcn_s_barrier(); asm volatile("" ::: "memory");
}
struct EpiProj {
    static constexpr bool PERM = true, AFTER_DRAIN = false, APERM = false;
    bf16_t* proj; const float* ssq; float* lnstat; PG8_LAS float* rl;
    __device__ __forceinline__ void operator()(const f32x4 (&acc)[2][2][4][2], const pg8::Unit& u, int wr, int wc, int fr_in, int fq_in) const {
        (void)fr_in; (void)fq_in; const int lane = otid() & 63, fr = lane & 15, fq = lane >> 4;
        const int row0 = u.pm * 256 + wr * 64 + fr, col0 = u.pn * 256 + wc * 32 + 8 * fq;
        const int mode = (u.pn == 4 || u.pn == 5) ? 2 : 3;
        rtable_build(ssq, u.pm * 256, wr, wc, fr, fq, rl);
#pragma unroll
        for (int ai = 0; ai < 2; ++ai)
#pragma unroll
            for (int m = 0; m < 4; ++m) {
                const int row = row0 + ai * 128 + m * 16;
                const float r = rl[ai * 128 + wr * 64 + m * 16 + fr];
                float s1 = 0.f, s2 = 0.f;
                bf16_t* rp = proj + (size_t)row * PROJ_LD + col0;
#pragma unroll
                for (int bj = 0; bj < 2; ++bj) {
                    f32x4 v0 = acc[ai][bj][m][0] * r, v1 = acc[ai][bj][m][1] * r;
                    if (mode == 0 || mode == 2) {
                        const f32x2 a = gelu_pk((f32x2){v0[0], v0[1]}), b = gelu_pk((f32x2){v0[2], v0[3]}), c = gelu_pk((f32x2){v1[0], v1[1]}), d = gelu_pk((f32x2){v1[2], v1[3]});
                        v0 = (f32x4){a.x, a.y, b.x, b.y}; v1 = (f32x4){c.x, c.y, d.x, d.y};
                    } else if (mode == 1) {
#pragma unroll
                        for (int j = 0; j < 4; ++j) { v0[j] = sigmoid_f(v0[j]); v1[j] = sigmoid_f(v1[j]); }
                    }
                    if (mode == 2) {
                        s1 += sum4(v0) + sum4(v1);
                        s2 += sum4(v0 * v0) + sum4(v1 * v1);
                    }
                    u32x4 w; w.x = cvt_pk_bf16(v0[0], v0[1]); w.y = cvt_pk_bf16(v0[2], v0[3]); w.z = cvt_pk_bf16(v1[0], v1[1]); w.w = cvt_pk_bf16(v1[2], v1[3]);
                    *(u32x4*)(rp + bj * 128) = w;
                }
                if (mode == 2) {
                    s1 += shx(s1, 16, lane); s1 += shx(s1, 32, lane);
                    s2 += shx(s2, 16, lane); s2 += shx(s2, 32, lane);
                    if (fq == 0) { float* st = lnstat + (size_t)row * 16 + ((u.pn - 4) * 4 + wc) * 2; st[0] = s1; st[1] = s2; }
                }
            }
    }
};
struct EpiResid {
    static constexpr bool PERM = true, AFTER_DRAIN = false, APERM = false;
    const float* xin; float* xout; bf16_t* xb; float* ssq; int row_off; int dry;
    __device__ __forceinline__ void operator()(const f32x4 (&acc)[2][2][4][2], const pg8::Unit& u, int wr, int wc, int fr_in, int fq_in) const {
        (void)fr_in; (void)fq_in; const int lane = otid() & 63, fr = lane & 15, fq = lane >> 4;
        const int row0 = row_off + u.pm * 256 + wr * 64 + fr, col0 = u.pn * 256 + wc * 32 + 8 * fq;
        f32x4 xa[2][2][2], xc[2][2][2];
#define RESID_LD(q, buf) do { _Pragma("unroll") for (int mm = 0; mm < 2; ++mm) _Pragma("unroll") for (int bj = 0; bj < 2; ++bj) { \
            const float* xi = xin + (size_t)(row0 + ((q) >> 1) * 128 + (((q) & 1) * 2 + mm) * 16) * DM + col0 + bj * 128; buf[mm][bj][0] = *(const f32x4*)xi; buf[mm][bj][1] = *(const f32x4*)(xi + 4); } } while (0)
#define RESID_ST(q, buf) do { _Pragma("unroll") for (int mm = 0; mm < 2; ++mm) { const int ai = (q) >> 1, m = ((q) & 1) * 2 + mm, row = row0 + ai * 128 + m * 16; const size_t base = (size_t)row * DM + col0; float s = 0.f; \
            _Pragma("unroll") for (int bj = 0; bj < 2; ++bj) { const f32x4 v0 = acc[ai][bj][m][0] + buf[mm][bj][0], v1 = acc[ai][bj][m][1] + buf[mm][bj][1]; float* xo = xout + base + bj * 128; \
                if (!dry) { *(f32x4*)xo = v0; *(f32x4*)(xo + 4) = v1; } s += sum4(v0 * v0) + sum4(v1 * v1); \
                u32x4 w; w.x = cvt_pk_bf16(v0[0], v0[1]); w.y = cvt_pk_bf16(v0[2], v0[3]); w.z = cvt_pk_bf16(v1[0], v1[1]); w.w = cvt_pk_bf16(v1[2], v1[3]); if (!dry) *(u32x4*)(xb + base + bj * 128) = w; } \
            s += shx(s, 16, lane); s += shx(s, 32, lane); if (fq == 0 && (!dry || s == 12345.678f)) ssq[(size_t)row * 16 + u.pn * 4 + wc] = s; } } while (0)
        RESID_LD(0, xa); RESID_LD(1, xc);
        RESID_ST(0, xa); RESID_LD(2, xa);
        RESID_ST(1, xc); RESID_LD(3, xc);
        RESID_ST(2, xa);
        RESID_ST(3, xc);
#undef RESID_LD
#undef RESID_ST
    }
};
__device__ __forceinline__ float dpp_ror1(float v) { return __builtin_bit_cast(float, __builtin_amdgcn_mov_dpp(__builtin_bit_cast(int, v), 0x121, 0xf, 0xf, true)); }
__device__ __forceinline__ float dpp_shr1(float v) { return __builtin_bit_cast(float, __builtin_amdgcn_mov_dpp(__builtin_bit_cast(int, v), 0x111, 0xf, 0xf, true)); }
__device__ __forceinline__ float dpp_ror2(float v) { return __builtin_bit_cast(float, __builtin_amdgcn_mov_dpp(__builtin_bit_cast(int, v), 0x122, 0xf, 0xf, true)); }
struct EpiUpAct {
    static constexpr bool PERM = true, AFTER_DRAIN = false, APERM = true;
    bf16_t* act; float* halo; const float* ssq; const float* cw; const float* cb; PG8_LAS float* rl;
    __device__ __forceinline__ void operator()(const f32x4 (&acc)[2][2][4][2], const pg8::Unit& u, int wr, int wc, int fr_in, int fq_in) const {
        (void)fr_in; (void)fq_in; const int lane = otid() & 63, fr = lane & 15, fq = lane >> 4;
        const int rowb = u.pm * 256 + wr * 64, ch0 = u.pn * 128 + wc * 32 + 8 * fq;
        PG8_LAS f32x4* wt = (PG8_LAS f32x4*)(rl + 256) + wr * 256;
        {
            const int t = wc * 64 + fq * 16 + fr, c = t >> 1, part = t & 1;
            const float* wp = cw + u.pn * 128 + c + part * DFF;
            f32x4 v; v[0] = wp[0]; v[1] = wp[UPN]; v[2] = wp[2 * UPN]; v[3] = cb[u.pn * 128 + c + part * DFF];
            wt[t] = v;
        }
        rtable_build(ssq, u.pm * 256, wr, wc, fr, fq, rl);
#pragma unroll
        for (int ai = 0; ai < 2; ++ai) {
            const int blk = (rowb + ai * 128) >> 6;
            if (fr == 0 || fr == 15) {
                const int mb = fr == 0 ? 0 : 2;
                const float ra = rl[ai * 128 + wr * 64 + 4 * fr + mb], rb2 = rl[ai * 128 + wr * 64 + 4 * fr + mb + 1];
                float* hp = halo + (size_t)(blk * 4 + mb) * UPN + ch0;
#pragma unroll
                for (int n = 0; n < 2; ++n) {
                    const f32x4 a0 = fr == 0 ? acc[ai][0][0][n] : acc[ai][0][2][n], a1 = fr == 0 ? acc[ai][0][1][n] : acc[ai][0][3][n];
                    const f32x4 b0 = fr == 0 ? acc[ai][1][0][n] : acc[ai][1][2][n], b1 = fr == 0 ? acc[ai][1][1][n] : acc[ai][1][3][n];
                    *(f32x4*)(hp + 4 * n) = a0 * ra; *(f32x4*)(hp + DFF + 4 * n) = b0 * ra;
                    *(f32x4*)(hp + UPN + 4 * n) = a1 * rb2; *(f32x4*)(hp + UPN + DFF + 4 * n) = b1 * rb2;
                }
            }
        }
        __builtin_amdgcn_sched_barrier(0);
#pragma unroll
        for (int ai = 0; ai < 2; ++ai) {
            const int rb = rowb + ai * 128;
            const f32x4 r4 = *(const PG8_LAS f32x4*)(rl + ai * 128 + wr * 64 + 4 * fr);
            unsigned pk[4][4];
#pragma unroll
            for (int n = 0; n < 2; ++n) {
                float oprev[4];
#pragma unroll
                for (int j = 0; j < 4; ++j) {
                    const int cl = wc * 32 + 8 * fq + 4 * n + j;
                    const f32x4 wa = wt[cl * 2], wb = wt[cl * 2 + 1];
                    float s[4];
                    {
                        float x[4];
#pragma unroll
                        for (int m = 0; m < 4; ++m) x[m] = acc[ai][0][m][n][j] * r4[m];
                        const float q3 = dpp_shr1(x[3]), q2 = dpp_shr1(x[2]);
                        s[0] = silu_f(wa[3] + wa[0] * q2 + wa[1] * q3 + wa[2] * x[0]);
                        s[1] = silu_f(wa[3] + wa[0] * q3 + wa[1] * x[0] + wa[2] * x[1]);
                        s[2] = silu_f(wa[3] + wa[0] * x[0] + wa[1] * x[1] + wa[2] * x[2]);
                        s[3] = silu_f(wa[3] + wa[0] * x[1] + wa[1] * x[2] + wa[2] * x[3]);
                    }
                    {
                        float x[4];
#pragma unroll
                        for (int m = 0; m < 4; ++m) x[m] = acc[ai][1][m][n][j] * r4[m];
                        const float q3 = dpp_shr1(x[3]), q2 = dpp_shr1(x[2]);
                        s[0] *= wb[3] + wb[0] * q2 + wb[1] * q3 + wb[2] * x[0];
                        s[1] *= wb[3] + wb[0] * q3 + wb[1] * x[0] + wb[2] * x[1];
                        s[2] *= wb[3] + wb[0] * x[0] + wb[1] * x[1] + wb[2] * x[2];
                        s[3] *= wb[3] + wb[0] * x[1] + wb[1] * x[2] + wb[2] * x[3];
                    }
#pragma unroll
                    for (int m = 0; m < 4; ++m) { if (j & 1) pk[m][2 * n + (j >> 1)] = cvt_pk_bf16(oprev[m], s[m]); else oprev[m] = s[m]; }
                    __builtin_amdgcn_sched_barrier(0);
                }
            }
#pragma unroll
            for (int m = 0; m < 4; ++m) {
                if (m > 1 || fr > 0) { u32x4 w; w.x = pk[m][0]; w.y = pk[m][1]; w.z = pk[m][2]; w.w = pk[m][3]; *(u32x4*)(act + (size_t)(rb + 4 * fr + m) * DFF + ch0) = w; }
            }
        }
    }
};
struct EpiPe {
    static constexpr bool PERM = true, AFTER_DRAIN = false, APERM = false;
    bf16_t* pe;
    __device__ __forceinline__ void operator()(const f32x4 (&acc)[2][2][4][2], const pg8::Unit& u, int wr, int wc, int fr_in, int fq_in) const {
        (void)fr_in; (void)fq_in; const int lane = otid() & 63, fr = lane & 15, fq = lane >> 4;
        const int row0 = u.pm * 256 + wr * 64 + fr, col0 = u.pn * 256 + wc * 32 + 8 * fq;
#pragma unroll
        for (int ai = 0; ai < 2; ++ai)
#pragma unroll
            for (int m = 0; m < 4; ++m) {
                const int row = row0 + ai * 128 + m * 16;
                bf16_t* rp = pe + (size_t)row * DM + col0;
#pragma unroll
                for (int bj = 0; bj < 2; ++bj) {
                    const f32x4 v0 = acc[ai][bj][m][0], v1 = acc[ai][bj][m][1];
                    u32x4 w; w.x = cvt_pk_bf16(v0[0], v0[1]); w.y = cvt_pk_bf16(v0[2], v0[3]); w.z = cvt_pk_bf16(v1[0], v1[1]); w.w = cvt_pk_bf16(v1[2], v1[3]);
                    *(u32x4*)(rp + bj * 128) = w;
                }
            }
    }
};
struct EpiGate {
    static constexpr bool PERM = true, AFTER_DRAIN = false, APERM = false;
    float* x; const bf16_t* pe; const float* ssq_in; bf16_t* xb; float* ssq; PG8_LAS float* rl; int dry;
    __device__ __forceinline__ void operator()(const f32x4 (&acc)[2][2][4][2], const pg8::Unit& u, int wr, int wc, int fr_in, int fq_in) const {
        (void)fr_in; (void)fq_in; const int lane = otid() & 63, fr = lane & 15, fq = lane >> 4;
        const int row0 = u.pm * 256 + wr * 64 + fr, col0 = u.pn * 256 + wc * 32 + 8 * fq;
        rtable_build(ssq_in, u.pm * 256, wr, wc, fr, fq, rl);
        f32x4 xa[2][2][2]; u32x4 pa[2][2];
#define GATE_LD(q, buf, pbuf) do { _Pragma("unroll") for (int mm = 0; mm < 2; ++mm) _Pragma("unroll") for (int bj = 0; bj < 2; ++bj) { \
            const size_t off = (size_t)(row0 + ((q) >> 1) * 128 + (((q) & 1) * 2 + mm) * 16) * DM + col0 + bj * 128; buf[mm][bj][0] = *(const f32x4*)(x + off); buf[mm][bj][1] = *(const f32x4*)(x + off + 4); pbuf[mm][bj] = *(const u32x4*)(pe + off); } } while (0)
#define GATE_ST(q, buf, pbuf) do { _Pragma("unroll") for (int mm = 0; mm < 2; ++mm) { const int ai = (q) >> 1, m = ((q) & 1) * 2 + mm, row = row0 + ai * 128 + m * 16; const size_t base = (size_t)row * DM + col0; float s = 0.f; \
            const float r = rl[ai * 128 + wr * 64 + m * 16 + fr]; \
            _Pragma("unroll") for (int bj = 0; bj < 2; ++bj) { f32x4 g0 = acc[ai][bj][m][0] * r, g1 = acc[ai][bj][m][1] * r; \
                _Pragma("unroll") for (int j = 0; j < 4; ++j) { g0[j] = sigmoid_f(g0[j]); g1[j] = sigmoid_f(g1[j]); } \
                const u32x4 pv = pbuf[mm][bj]; const f32x4 p0 = (f32x4){bflo(pv.x), bfhi(pv.x), bflo(pv.y), bfhi(pv.y)}, p1 = (f32x4){bflo(pv.z), bfhi(pv.z), bflo(pv.w), bfhi(pv.w)}; \
                const f32x4 v0 = buf[mm][bj][0] + g0 * p0, v1 = buf[mm][bj][1] + g1 * p1; float* xo = x + base + bj * 128; \
                if (!dry) { *(f32x4*)xo = v0; *(f32x4*)(xo + 4) = v1; } s += sum4(v0 * v0) + sum4(v1 * v1); \
                u32x4 w; w.x = cvt_pk_bf16(v0[0], v0[1]); w.y = cvt_pk_bf16(v0[2], v0[3]); w.z = cvt_pk_bf16(v1[0], v1[1]); w.w = cvt_pk_bf16(v1[2], v1[3]); if (!dry) *(u32x4*)(xb + base + bj * 128) = w; } \
            s += shx(s, 16, lane); s += shx(s, 32, lane); if (fq == 0 && (!dry || s == 12345.678f)) ssq[(size_t)row * 16 + u.pn * 4 + wc] = s; } } while (0)
        GATE_LD(0, xa, pa); GATE_ST(0, xa, pa);
        GATE_LD(1, xa, pa); GATE_ST(1, xa, pa);
        GATE_LD(2, xa, pa); GATE_ST(2, xa, pa);
        GATE_LD(3, xa, pa); GATE_ST(3, xa, pa);
#undef GATE_LD
#undef GATE_ST
    }
};

template <class Epi>
__device__ __forceinline__ void run_gemm(ldsp lds, const bf16_t* A, int lda, const bf16_t* Bt, int M, int N, int K, const Epi& E) {
    pg8::Gemm g; g.A = A; g.Bt = Bt; g.M = M; g.N = N; g.K = K; g.lda = lda;
    pg8::StaticOrder S; S.init(M, N, (int)gridDim.x, obid());
    pg8::gemm_phase<Epi, pg8::StaticOrder>(lds, g, S, E);
}

__device__ __forceinline__ void tr_tile(ldsp lds, const float* __restrict__ src, int ld, int c0, int k0, const float* __restrict__ g, bf16_t* __restrict__ dst, int Kd, int n0) {
    PG8_LAS float* tile = (PG8_LAS float*)lds;
    const int tid = otid();
#pragma unroll
    for (int i = 0; i < 2; ++i) {
        const int q = tid + i * 512, kr = q >> 4, c4 = (q & 15) * 4;
        const f32x4 v = *(const f32x4*)(src + (size_t)(k0 + kr) * ld + c0 + c4);
        const float s = g ? g[k0 + kr] : 1.f;
        tile[kr * 65 + c4 + 0] = v[0] * s; tile[kr * 65 + c4 + 1] = v[1] * s; tile[kr * 65 + c4 + 2] = v[2] * s; tile[kr * 65 + c4 + 3] = v[3] * s;
    }
    __syncthreads();
    {
        const int n = tid >> 3, kc = (tid & 7) * 8;
        float f[8];
#pragma unroll
        for (int j = 0; j < 8; ++j) f[j] = tile[(kc + j) * 65 + n];
        u32x4 w; w.x = cvt_pk_bf16(f[0], f[1]); w.y = cvt_pk_bf16(f[2], f[3]); w.z = cvt_pk_bf16(f[4], f[5]); w.w = cvt_pk_bf16(f[6], f[7]);
        *(u32x4*)(dst + (size_t)(n0 + n) * Kd + k0 + kc) = w;
    }
    __syncthreads();
}

__device__ __forceinline__ void prep_phase(ldsp lds, KP p) {
    const int tid = otid(), lane = tid & 63, w = __builtin_amdgcn_readfirstlane(tid >> 6);
    unsigned char* ws = p->ws;
    for (int j = obid(); j < 4 * 3456; j += gridDim.x) {
        const int l = j / 3456; int r = j % 3456;
        unsigned char* wt = ws + WS_WT + (size_t)l * WT_LAYER;
        const float* src; const float* g = nullptr; bf16_t* dst; int ld, c0, k0, Kd, n0;
        if (r < 768) { const int kt = r & 15, nt = r >> 4; n0 = nt * 64; k0 = kt * 64; src = p->in[3] + (size_t)l * 1024 * 3080; ld = 3080; c0 = n0 < 512 ? n0 : (n0 < 1024 ? n0 + 2048 : n0 - 512); g = p->in[2] + l * 1024; dst = (bf16_t*)(wt + WT_IN); Kd = 1024; }
        else if (r < 1024) { r -= 768; const int kt = r & 15, nt = r >> 4; n0 = nt * 64; k0 = kt * 64; src = p->in[13] + (size_t)l * 1024 * 1024; ld = 1024; c0 = n0; dst = (bf16_t*)(wt + WT_OUT); Kd = 1024; }
        else if (r < 2432) { r -= 1024; const int kt = r & 15, nt = r >> 4; n0 = nt * 64; k0 = kt * 64; src = p->in[15] + (size_t)l * 1024 * 5632; ld = 5632; c0 = ((n0 & 255) >> 7) * DFF + (n0 >> 8) * 128 + (n0 & 127); g = p->in[14] + l * 1024; dst = (bf16_t*)(wt + WT_UP); Kd = 1024; }
        else if (r < 3136) { r -= 2432; const int kt = r % 44, nt = r / 44; n0 = nt * 64; k0 = kt * 64; src = p->in[18] + (size_t)l * 2816 * 1024; ld = 1024; c0 = n0; dst = (bf16_t*)(wt + WT_DOWN); Kd = 2816; }
        else if (r < 3392) { r -= 3136; const int kt = r & 15, nt = r >> 4; n0 = nt * 64; k0 = kt * 64; src = p->in[20] + (size_t)l * 1024 * 1024; ld = 1024; c0 = n0; g = p->in[19] + l * 1024; dst = (bf16_t*)(wt + WT_GATE); Kd = 1024; }
        else { r -= 3392; const int kt = r & 3, nt = r >> 2; n0 = nt * 64; k0 = kt * 64; src = p->in[21] + (size_t)l * 256 * 1024; ld = 1024; c0 = n0; dst = (bf16_t*)(wt + WT_PLE); Kd = 256; }
        tr_tile(lds, src, ld, c0, k0, g, dst, Kd, n0);
    }
    const int gtid = obid() * 512 + tid, gthreads = gridDim.x * 512;
    for (int i = gtid; i < 4 * 8 * 128 * 16; i += gthreads) {
        const int l = i >> 14, rem = i & 16383, h = rem >> 11, t = (rem >> 4) & 127, s0 = (rem & 15) * 8;
        const float* src = p->in[6] + (size_t)i * 8;
        const f32x4 a = *(const f32x4*)src, b = *(const f32x4*)(src + 4);
        float f[8] = {a[0], a[1], a[2], a[3], b[0], b[1], b[2], b[3]};
#pragma unroll
        for (int j = 0; j < 8; ++j) f[j] = (s0 + j <= t) ? f[j] : 0.f;
        u32x4 wv; wv.x = cvt_pk_bf16(f[0], f[1]); wv.y = cvt_pk_bf16(f[2], f[3]); wv.z = cvt_pk_bf16(f[4], f[5]); wv.w = cvt_pk_bf16(f[6], f[7]);
        bf16_t* dst = (bf16_t*)(ws + WS_WT + (size_t)l * WT_LAYER + WT_WSB) + (size_t)(h * 128 + t) * 128 + s0;
        *(u32x4*)dst = wv;
    }
    for (int i = gtid; i < 4 * 1024 * 8; i += gthreads) {
        const int l = i >> 13, k = (i >> 3) & 1023, j = i & 7;
        ((float*)(ws + WS_WG))[i] = p->in[3][((size_t)l * 1024 + k) * 3080 + 3072 + j] * p->in[2][l * 1024 + k];
    }
    bf16_t* xb0 = (bf16_t*)(ws + WS_XB0); float* ssq0 = (float*)(ws + WS_SSQ0);
    for (int rowb = obid() * 8 + w; rowb < NTOK; rowb += gridDim.x * 8 * 4) {
        const int rstep = gridDim.x * 8;
        f32x4 xv[4][4];
#pragma unroll
        for (int u = 0; u < 4; ++u) { const int row = rowb + u * rstep < NTOK ? rowb + u * rstep : rowb;
#pragma unroll
            for (int i = 0; i < 4; ++i) xv[u][i] = *(const f32x4*)(p->in[0] + (size_t)row * DM + i * 256 + lane * 4); }
#pragma unroll
        for (int u = 0; u < 4; ++u) {
            const int row = rowb + u * rstep; float s = 0.f;
            if (row < NTOK) {
#pragma unroll
                for (int i = 0; i < 4; ++i) {
                    const f32x4 v = xv[u][i]; s += sum4(v * v);
                    u32x2 pk; pk.x = cvt_pk_bf16(v[0], v[1]); pk.y = cvt_pk_bf16(v[2], v[3]);
                    *(u32x2*)(xb0 + (size_t)row * DM + i * 256 + lane * 4) = pk;
                }
                s = wave_sum(s, lane);
                if (lane < 16) ssq0[(size_t)row * 16 + lane] = lane == 0 ? s : 0.f;
            }
        }
    }
}

__device__ __forceinline__ void gates_phase(ldsp lds, KP p, int l, const bf16_t* xb, const float* ssq, int part) {
    const int tid = otid(), lane = tid & 63, w = __builtin_amdgcn_readfirstlane(tid >> 6), fr = lane & 15, fq = lane >> 4;
    ldsp wt = lds;
    const float* wg = (const float*)(p->ws + WS_WG) + l * 8192;
    {
        const int k0 = tid * 2;
        const f32x4 a0 = *(const f32x4*)(wg + k0 * 8), a1 = *(const f32x4*)(wg + k0 * 8 + 4), b0 = *(const f32x4*)(wg + k0 * 8 + 8), b1 = *(const f32x4*)(wg + k0 * 8 + 12);
        const float v0[8] = {a0[0], a0[1], a0[2], a0[3], a1[0], a1[1], a1[2], a1[3]}, v1[8] = {b0[0], b0[1], b0[2], b0[3], b1[0], b1[1], b1[2], b1[3]};
#pragma unroll
        for (int n = 0; n < 8; ++n) {
            *(PG8_LAS unsigned*)(wt + n * 2048 + ((((k0 >> 3) ^ n) & 127) << 4) + (k0 & 7) * 2) = cvt_pk_bf16(v0[n], v1[n]);
            *(PG8_LAS unsigned*)(wt + (n + 8) * 2048 + ((((k0 >> 3) ^ (n + 8)) & 127) << 4) + (k0 & 7) * 2) = 0u;
        }
    }
    __syncthreads();
    float* gates = (float*)(p->ws + WS_GATES);
    int G8 = (int)gridDim.x * 8; asm volatile("" : "+s"(G8));
    const int nblk = NTOK / 16, per = (nblk + G8 - 1) / G8;
    const int b_lo = part == 1 ? per / 2 : 0, b_hi = part == 0 ? per / 2 : per;
    for (int bi = b_lo; bi < b_hi; ++bi) {
        const int blk = (obid() * 8 + w) * per + bi;
        if (blk >= nblk) break;
        const int row = blk * 16 + fr;
        const bf16_t* xr = xb + (size_t)row * DM + fq * 8;
        const float r = rowscale(ssq, row);
        f32x4 acc = (f32x4){0.f, 0.f, 0.f, 0.f};
#pragma unroll
        for (int kb = 0; kb < 4; ++kb) {
            bf16x8 a[8];
#pragma unroll
            for (int i = 0; i < 8; ++i) a[i] = *(const bf16x8*)(xr + (kb * 8 + i) * 32);
#pragma unroll
            for (int i = 0; i < 8; ++i) {
                const int ch = (kb * 8 + i) * 4 + fq;
                const bf16x8 b = *(const PG8_LAS bf16x8*)(wt + fr * 2048 + (((ch ^ fr) & 127) << 4));
                acc = __builtin_amdgcn_mfma_f32_16x16x32_bf16(b, a[i], acc, 0, 0, 0);
            }
        }
        if (fq < 2) {
            f32x4 o;
#pragma unroll
            for (int j = 0; j < 4; ++j) {
                const float z = r * acc[j] + (fq == 0 ? p->in[10][l * 4 + j] : p->in[11][l * 4 + j]);
                o[j] = fq == 0 ? z : fminf(z, 0.f) - __logf(1.0f + __expf(-fabsf(z)));
            }
            *(f32x4*)(gates + (size_t)row * 8 + fq * 4) = o;
        }
    }
    __syncthreads();
}

template <int NT>
__device__ __forceinline__ void strip_mma(ldsp A, int arow0, ldsp Bt, f32x4 (&acc)[NT], int lane, int kk_lo, int kk_hi, int nt_hi) {
    const int fr = lane & 15, fq = lane >> 4;
    for (int kk = kk_lo; kk < kk_hi; ++kk) {
        const int ch = kk * 4 + fq;
        const bf16x8 a = *(const PG8_LAS bf16x8*)(A + swz(arow0 + fr, ch));
#pragma unroll
        for (int nt = 0; nt < NT; ++nt) if (nt < nt_hi) {
            const bf16x8 b = *(const PG8_LAS bf16x8*)(Bt + swz(nt * 16 + fr, ch));
            acc[nt] = __builtin_amdgcn_mfma_f32_16x16x32_bf16(b, a, acc[nt], 0, 0, 0);
        }
    }
}

__device__ __forceinline__ void gmlp_task(ldsp lds, KP p, int l, int task, bool dry = false) {
    const int c = task >> 3, h = task & 7, tok0 = c * 128;
    const int tid = otid(), lane = tid & 63, w = __builtin_amdgcn_readfirstlane(tid >> 6);
    ldsp W = lds, VT = lds + 32768;
    bf16_t* proj = (bf16_t*)(p->ws + WS_PROJ);
    const bf16_t* wsb = (const bf16_t*)(p->ws + WS_WT + (size_t)l * WT_LAYER + WT_WSB) + (size_t)h * 16384;
    u32x4 wreg[4];
#pragma unroll
    for (int i = 0; i < 4; ++i) { const int q = tid + i * 512, row = q >> 4, ch = q & 15; wreg[i] = *(const u32x4*)(wsb + row * 128 + ch * 8); }
    {
        const int s = tid >> 2, cb = (tid & 3) * 16, tok = tok0 + s;
        const float* st = (const float*)(p->ws + WS_LNSTAT) + (size_t)tok * 16;
        const f32x4 a = *(const f32x4*)st, b = *(const f32x4*)(st + 4), c2 = *(const f32x4*)(st + 8), d = *(const f32x4*)(st + 12);
        const float s1 = (a[0] + a[2]) + (b[0] + b[2]) + (c2[0] + c2[2]) + (d[0] + d[2]);
        const float s2 = (a[1] + a[3]) + (b[1] + b[3]) + (c2[1] + c2[3]) + (d[1] + d[3]);
        const float mu = s1 * (1.0f / 512.0f), var = fmaxf(s2 * (1.0f / 512.0f) - mu * mu, 0.f), rstd = rsqrtf(var + EPS);
        const bf16_t* src = proj + (size_t)tok * PROJ_LD + 1024 + h * 64 + cb;
        const u32x4 r0 = *(const u32x4*)src, r1 = *(const u32x4*)(src + 8);
        const unsigned rw[8] = {r0.x, r0.y, r0.z, r0.w, r1.x, r1.y, r1.z, r1.w};
        const float* lgp = p->in[4] + l * 512 + h * 64 + cb; const float* lbp = p->in[5] + l * 512 + h * 64 + cb;
        const f32x4 g0 = *(const f32x4*)lgp, g1 = *(const f32x4*)(lgp + 4), g2 = *(const f32x4*)(lgp + 8), g3 = *(const f32x4*)(lgp + 12);
        const f32x4 b0 = *(const f32x4*)lbp, b1 = *(const f32x4*)(lbp + 4), b2 = *(const f32x4*)(lbp + 8), b3 = *(const f32x4*)(lbp + 12);
        const float lg[16] = {g0[0], g0[1], g0[2], g0[3], g1[0], g1[1], g1[2], g1[3], g2[0], g2[1], g2[2], g2[3], g3[0], g3[1], g3[2], g3[3]};
        const float lb[16] = {b0[0], b0[1], b0[2], b0[3], b1[0], b1[1], b1[2], b1[3], b2[0], b2[1], b2[2], b2[3], b3[0], b3[1], b3[2], b3[3]};
#pragma unroll
        for (int j = 0; j < 16; ++j) {
            const float x = (j & 1) ? bfhi(rw[j >> 1]) : bflo(rw[j >> 1]);
            const float y = (x - mu) * rstd * lg[j] + lb[j];
            const int dd = cb + j;
            *(PG8_LAS bf16_t*)(VT + dd * 256 + (((s >> 3) ^ (dd & 15)) << 4) + (s & 7) * 2) = f2bf(y);
        }
    }
#pragma unroll
    for (int i = 0; i < 4; ++i) { const int q = tid + i * 512, row = q >> 4, ch = q & 15; *(PG8_LAS u32x4*)(W + swz(row, ch)) = wreg[i]; }
    u32x2 uup[4]; float bs;
    {
        const int t = 16 * w + (lane & 15), tok = tok0 + t, fq = lane >> 4;
        bs = p->in[7][(l * 8 + h) * 128 + t];
#pragma unroll
        for (int nt = 0; nt < 4; ++nt) uup[nt] = *(const u32x2*)(proj + (size_t)tok * PROJ_LD + h * 64 + nt * 16 + fq * 4);
    }
    __syncthreads();
    f32x4 acc[4];
#pragma unroll
    for (int i = 0; i < 4; ++i) acc[i] = (f32x4){0.f, 0.f, 0.f, 0.f};
    const int kk_hi = (16 * w + 15) / 32 + 1;
    strip_mma<4>(W, 16 * w, VT, acc, lane, 0, kk_hi, 4);
    {
        const int t = 16 * w + (lane & 15), tok = tok0 + t, fq = lane >> 4;
#pragma unroll
        for (int nt = 0; nt < 4; ++nt) {
            bf16_t* up = proj + (size_t)tok * PROJ_LD + h * 64 + nt * 16 + fq * 4;
            const u32x2 uu = uup[nt];
            const f32x2 g0 = gelu_pk((f32x2){bflo(uu.x), bfhi(uu.x)}), g1 = gelu_pk((f32x2){bflo(uu.y), bfhi(uu.y)});
            u32x2 o; o.x = cvt_pk_bf16(g0.x * (acc[nt][0] + bs), g0.y * (acc[nt][1] + bs)); o.y = cvt_pk_bf16(g1.x * (acc[nt][2] + bs), g1.y * (acc[nt][3] + bs));
            if (!dry) *(u32x2*)up = o;
        }
    }
    __syncthreads();
}

__device__ __forceinline__ void conv_table_fill(PG8_LAS float* wts, const float* cw, const float* cb, int h, int tid) {
    if (tid < 320) {
        const int part = tid >> 6, c4 = (tid & 63) * 4, gch = c4 < 128 ? h * 128 + c4 : 512 + h * 128 + (c4 - 128);
        const f32x4 v = part < 4 ? *(const f32x4*)(cw + part * 1024 + gch) : *(const f32x4*)(cb + gch);
        *(PG8_LAS f32x4*)(wts + part * 256 + c4) = v;
    }
}
__device__ __forceinline__ void conv_rows_load(const bf16_t* proj, int tok, int spos, int col, u32x4 (&r)[4][2]) {
#pragma unroll
    for (int jj = 0; jj < 4; ++jj) {
        const bf16_t* src = proj + (size_t)(spos - 3 + jj >= 0 ? tok - 3 + jj : tok) * PROJ_LD + col;
        r[jj][0] = *(const u32x4*)src; r[jj][1] = *(const u32x4*)(src + 8);
    }
}
__device__ __forceinline__ void conv16_regs(const u32x4 (&r)[4][2], int spos, const PG8_LAS float* wts, int lc0, float (&o)[16]) {
#pragma unroll
    for (int q = 0; q < 4; ++q) { const f32x4 b = *(const PG8_LAS f32x4*)(wts + 4 * 256 + lc0 + q * 4); o[q * 4 + 0] = b[0]; o[q * 4 + 1] = b[1]; o[q * 4 + 2] = b[2]; o[q * 4 + 3] = b[3]; }
#pragma unroll
    for (int jj = 0; jj < 4; ++jj) {
        const float vm = spos - 3 + jj >= 0 ? 1.f : 0.f;
        const unsigned rw[8] = {r[jj][0].x, r[jj][0].y, r[jj][0].z, r[jj][0].w, r[jj][1].x, r[jj][1].y, r[jj][1].z, r[jj][1].w};
#pragma unroll
        for (int q = 0; q < 4; ++q) {
            const f32x4 wv = *(const PG8_LAS f32x4*)(wts + jj * 256 + lc0 + q * 4) * vm;
            o[q * 4 + 0] += wv[0] * bflo(rw[q * 2]); o[q * 4 + 1] += wv[1] * bfhi(rw[q * 2]);
            o[q * 4 + 2] += wv[2] * bflo(rw[q * 2 + 1]); o[q * 4 + 3] += wv[3] * bfhi(rw[q * 2 + 1]);
        }
    }
#pragma unroll
    for (int j = 0; j < 16; ++j) o[j] = silu_f(o[j]);
}

struct DcPre { u32x4 rk[2][4][2]; u32x4 rv[2][2]; float ig0, lf0, ig1, lf1; };
__device__ __forceinline__ void dc_prefetch(KP p, int cidx, int tid, DcPre& R) {
    const int n = cidx & 127, bh = cidx >> 7, h = bh & 3, b = bh >> 2, tok0 = b * SEQ + n * 128;
    const int lane = tid & 63, w = __builtin_amdgcn_readfirstlane(tid >> 6);
    const bf16_t* proj = (const bf16_t*)(p->ws + WS_PROJ);
    const int lr = tid >> 2, cb = (tid & 3) * 32, tok = tok0 + lr, spos = n * 128 + lr;
#pragma unroll
    for (int hf = 0; hf < 2; ++hf) {
        const int c0 = cb + hf * 16;
        conv_rows_load(proj, tok, spos, 2048 + h * 128 + c0, R.rk[hf]);
        const bf16_t* vs = proj + (size_t)tok * PROJ_LD + 2560 + h * 128 + c0;
        R.rv[hf][0] = *(const u32x4*)vs; R.rv[hf][1] = *(const u32x4*)(vs + 8);
    }
    if (w == 0) {
        const float* gates = (const float*)(p->ws + WS_GATES);
        const int l0 = 2 * lane;
        R.ig0 = gates[(size_t)(tok0 + l0) * 8 + h]; R.lf0 = gates[(size_t)(tok0 + l0) * 8 + 4 + h];
        R.ig1 = gates[(size_t)(tok0 + l0 + 1) * 8 + h]; R.lf1 = gates[(size_t)(tok0 + l0 + 1) * 8 + 4 + h];
    }
}
__device__ __forceinline__ void mlstm_dc_task(ldsp lds, KP p, int l, int cidx, DcPre& R, int next_cidx) {
    const int n = cidx & 127, bh = cidx >> 7, h = bh & 3;
    const int tid = otid(), lane = tid & 63, w = __builtin_amdgcn_readfirstlane(tid >> 6);
    ldsp KT = lds, VT = lds + 32768; PG8_LAS float* wl = (PG8_LAS float*)(lds + 131072);
    PG8_LAS float* wts = (PG8_LAS float*)(lds + 131072 + 2560);
    conv_table_fill(wts, p->in[8] + (size_t)l * 4096, p->in[9] + l * 1024, h, tid);
    const int lr = tid >> 2, cb = (tid & 3) * 32, spos = n * 128 + lr;
    if (w == 0) {
        const int l0 = 2 * lane;
        const float ig0 = R.ig0, lf0 = R.lf0, ig1 = R.ig1, lf1 = R.lf1;
        const float incl = wave_incl_sum(lf0 + lf1, lane);
        const float b1 = incl, b0 = incl - lf1, bL = __builtin_bit_cast(float, __builtin_amdgcn_readlane(__builtin_bit_cast(int, incl), 63));
        const float a0 = bL - b0 + ig0, a1 = bL - b1 + ig1;
        const float amax = wave_max(fmaxf(a0, a1), lane);
        wl[l0] = __expf(a0 - amax); wl[l0 + 1] = __expf(a1 - amax);
        if (lane == 0) { ((float*)(p->ws + WS_CHBL))[cidx] = bL; ((float*)(p->ws + WS_CHAMAX))[cidx] = amax; }
    }
    __syncthreads();
    {
        const float wgt = wl[lr] * 0.08838834764831845f;
#pragma unroll
        for (int hf = 0; hf < 2; ++hf) {
            const int c0 = cb + hf * 16;
            float o[16];
            conv16_regs(R.rk[hf], spos, wts, 128 + c0, o);
#pragma unroll
            for (int j = 0; j < 16; ++j) { const int d = c0 + j; *(PG8_LAS bf16_t*)(KT + d * 256 + (((lr >> 3) ^ (d & 15)) << 4) + (lr & 7) * 2) = f2bf(o[j] * wgt); }
            const unsigned rw[8] = {R.rv[hf][0].x, R.rv[hf][0].y, R.rv[hf][0].z, R.rv[hf][0].w, R.rv[hf][1].x, R.rv[hf][1].y, R.rv[hf][1].z, R.rv[hf][1].w};
#pragma unroll
            for (int j = 0; j < 16; ++j) { const int e = c0 + j; const unsigned v16 = (j & 1) ? (rw[j >> 1] >> 16) : (rw[j >> 1] & 0xffffu);
                *(PG8_LAS bf16_t*)(VT + e * 256 + (((lr >> 3) ^ (e & 15)) << 4) + (lr & 7) * 2) = (bf16_t)v16; }
        }
    }
    __syncthreads();
    if (next_cidx >= 0) dc_prefetch(p, next_cidx, tid, R);
    if (tid < 128) {
        const int d = tid; float s = 0.f;
#pragma unroll
        for (int pc = 0; pc < 16; ++pc) {
            const u32x4 v = *(const PG8_LAS u32x4*)(KT + d * 256 + ((pc ^ (d & 15)) << 4));
            s += (bflo(v.x) + bfhi(v.x)) + (bflo(v.y) + bfhi(v.y)) + (bflo(v.z) + bfhi(v.z)) + (bflo(v.w) + bfhi(v.w));
        }
        ((float*)(p->ws + WS_DN))[(size_t)cidx * 128 + d] = s;
    }
    f32x4 acc[8];
#pragma unroll
    for (int i = 0; i < 8; ++i) acc[i] = (f32x4){0.f, 0.f, 0.f, 0.f};
    strip_mma<8>(VT, 16 * w, KT, acc, lane, 0, 4, 8);
    {
        const int e = 16 * w + (lane & 15), fq = lane >> 4;
        bf16_t* dst = (bf16_t*)(p->ws + WS_DC) + ((size_t)cidx * 128 + e) * 128 + fq * 4;
#pragma unroll
        for (int nt = 0; nt < 8; ++nt) { u32x2 o; o.x = cvt_pk_bf16(acc[nt][0], acc[nt][1]); o.y = cvt_pk_bf16(acc[nt][2], acc[nt][3]); *(u32x2*)(dst + nt * 16) = o; }
    }
    __syncthreads();
}
__device__ __forceinline__ void mlstm_dc_all(ldsp lds, KP p, int l) {
    const int G = (int)gridDim.x; int t = obid();
    if (t >= 1024) return;
    DcPre R;
    R.ig0 = R.lf0 = R.ig1 = R.lf1 = 0.f;
    dc_prefetch(p, t, otid(), R);
    for (; t < 1024; t += G) mlstm_dc_task(lds, p, l, t, R, t + G < 1024 ? t + G : -1);
}

__device__ __forceinline__ void scan_phase(KP p, bool dry = false) {
    const int gtid = obid() * 512 + otid(), gthreads = gridDim.x * 512;
    const float* __restrict__ chbl = (const float*)(p->ws + WS_CHBL); const float* __restrict__ cham = (const float*)(p->ws + WS_CHAMAX);
    float* m0 = (float*)(p->ws + WS_CHM0);
    for (int idx = gtid; idx < 8 * 16384; idx += gthreads) {
        const int bh = idx >> 14, el = idx & 16383;
        bf16_t* ptr = (bf16_t*)(p->ws + WS_DC) + (size_t)bh * 128 * 16384 + el;
        const bool hasn = idx < 1024;
        const int bh2 = (idx >> 7) & 7, d2 = idx & 127;
        float* nptr = (float*)(p->ws + WS_DN) + (size_t)bh2 * 128 * 128 + d2;
        float C = 0.f, m = 0.f, nv = 0.f, m2 = 0.f;
        for (int c0 = 0; c0 < 128; c0 += 16) {
            float d[16], bl[16], am[16], dn[16], bl2[16], am2[16];
#pragma unroll
            for (int u = 0; u < 16; ++u) { d[u] = bf2f(ptr[(size_t)(c0 + u) * 16384]); bl[u] = chbl[bh * 128 + c0 + u]; am[u] = cham[bh * 128 + c0 + u]; }
            if (hasn) {
#pragma unroll
                for (int u = 0; u < 16; ++u) { dn[u] = nptr[(c0 + u) * 128]; bl2[u] = chbl[bh2 * 128 + c0 + u]; am2[u] = cham[bh2 * 128 + c0 + u]; }
            }
#pragma unroll
            for (int u = 0; u < 16; ++u) {
                const float mn = fmaxf(bl[u] + m, am[u]), dec = __expf(bl[u] + m - mn), sc = __expf(am[u] - mn);
                if (!dry) ptr[(size_t)(c0 + u) * 16384] = f2bf(C);
                C = dec * C + sc * d[u]; m = mn;
            }
            if (hasn) {
#pragma unroll
                for (int u = 0; u < 16; ++u) {
                    const float mn = fmaxf(bl2[u] + m2, am2[u]), dec = __expf(bl2[u] + m2 - mn), sc = __expf(am2[u] - mn);
                    if (!dry) { nptr[(c0 + u) * 128] = nv;
                    if (d2 == 0) m0[bh2 * 128 + c0 + u] = m2; }
                    nv = dec * nv + sc * dn[u]; m2 = mn;
                }
            }
        }
        if (dry && C == 12345.678f && nv == 3.25f) m0[0] = C + nv + m + m2;
    }
}

__device__ __forceinline__ void mlstm_out_task(ldsp lds, KP p, int l, int cidx, bool dry = false) {
    const int n = cidx & 127, bh = cidx >> 7, h = bh & 3, b = bh >> 2, tok0 = b * SEQ + n * 128;
    const int tid = otid(), lane = tid & 63, w = __builtin_amdgcn_readfirstlane(tid >> 6), fr = lane & 15, fq = lane >> 4;
    ldsp Q = lds, KP = lds + 32768, VT = lds + 65536, CT = lds + 98304;
    PG8_LAS float* gA = (PG8_LAS float*)(lds + 131072); PG8_LAS float* MA = gA + 128; PG8_LAS float* bA = gA + 256; PG8_LAS float* dq = gA + 384; PG8_LAS float* n0s = gA + 512;
    bf16_t* proj = (bf16_t*)(p->ws + WS_PROJ);
    const float* gates = (const float*)(p->ws + WS_GATES);
    const float m0 = ((const float*)(p->ws + WS_CHM0))[cidx];
    if (w == 0) {
        const int l0 = 2 * lane;
        const float ig0 = gates[(size_t)(tok0 + l0) * 8 + h], lf0 = gates[(size_t)(tok0 + l0) * 8 + 4 + h];
        const float ig1 = gates[(size_t)(tok0 + l0 + 1) * 8 + h], lf1 = gates[(size_t)(tok0 + l0 + 1) * 8 + 4 + h];
        const float incl = wave_incl_sum(lf0 + lf1, lane);
        const float b1 = incl, b0 = incl - lf1;
        const float g0 = ig0 - b0, g1 = ig1 - b1;
        const float pm = wave_incl_max(fmaxf(g0, g1), lane);
        float ex = shup(pm, 1, lane); if (lane == 0) ex = -INFINITY;
        const float pm0 = fmaxf(ex, g0), pm1 = pm;
        gA[l0] = g0; gA[l0 + 1] = g1; bA[l0] = b0; bA[l0 + 1] = b1;
        MA[l0] = fmaxf(pm0, m0); MA[l0 + 1] = fmaxf(pm1, m0);
    }
    if (tid >= 128 && tid < 256) n0s[tid - 128] = ((const float*)(p->ws + WS_DN))[(size_t)cidx * 128 + tid - 128];
    PG8_LAS float* wts = (PG8_LAS float*)(lds + 131072 + 2560);
    conv_table_fill(wts, p->in[8] + (size_t)l * 4096, p->in[9] + l * 1024, h, tid);
    if (tid >= 320 && tid < 352) *(PG8_LAS f32x4*)(wts + 1280 + (tid - 320) * 4) = *(const f32x4*)(p->in[12] + l * 512 + h * 128 + (tid - 320) * 4);
    {
        const int lr = tid >> 2, cb = (tid & 3) * 32, tok = tok0 + lr, spos = n * 128 + lr;
        const bf16_t* cs = (const bf16_t*)(p->ws + WS_DC) + (size_t)cidx * 16384;
        u32x4 rc[4];
#pragma unroll
        for (int i = 0; i < 4; ++i) { const int q = tid + i * 512, row = q >> 4, ch = q & 15; rc[i] = *(const u32x4*)(cs + row * 128 + ch * 8); }
        u32x4 rq[4][2], rk[4][2], rv[2];
        conv_rows_load(proj, tok, spos, 1536 + h * 128 + cb, rq);
        conv_rows_load(proj, tok, spos, 2048 + h * 128 + cb, rk);
        { const bf16_t* vs = proj + (size_t)tok * PROJ_LD + 2560 + h * 128 + cb; rv[0] = *(const u32x4*)vs; rv[1] = *(const u32x4*)(vs + 8); }
        __syncthreads();
#pragma unroll
        for (int hf = 0; hf < 2; ++hf) {
            const int c0 = cb + hf * 16;
            float o[16];
            conv16_regs(rq, spos, wts, c0, o);
            u32x4 w0, w1;
            w0.x = cvt_pk_bf16(o[0], o[1]); w0.y = cvt_pk_bf16(o[2], o[3]); w0.z = cvt_pk_bf16(o[4], o[5]); w0.w = cvt_pk_bf16(o[6], o[7]);
            w1.x = cvt_pk_bf16(o[8], o[9]); w1.y = cvt_pk_bf16(o[10], o[11]); w1.z = cvt_pk_bf16(o[12], o[13]); w1.w = cvt_pk_bf16(o[14], o[15]);
            *(PG8_LAS u32x4*)(Q + swz(lr, c0 >> 3)) = w0; *(PG8_LAS u32x4*)(Q + swz(lr, (c0 >> 3) + 1)) = w1;
            conv16_regs(rk, spos, wts, 128 + c0, o);
            const float ks = 0.08838834764831845f;
            w0.x = cvt_pk_bf16(o[0] * ks, o[1] * ks); w0.y = cvt_pk_bf16(o[2] * ks, o[3] * ks); w0.z = cvt_pk_bf16(o[4] * ks, o[5] * ks); w0.w = cvt_pk_bf16(o[6] * ks, o[7] * ks);
            w1.x = cvt_pk_bf16(o[8] * ks, o[9] * ks); w1.y = cvt_pk_bf16(o[10] * ks, o[11] * ks); w1.z = cvt_pk_bf16(o[12] * ks, o[13] * ks); w1.w = cvt_pk_bf16(o[14] * ks, o[15] * ks);
            *(PG8_LAS u32x4*)(KP + swz(lr, c0 >> 3)) = w0; *(PG8_LAS u32x4*)(KP + swz(lr, (c0 >> 3) + 1)) = w1;
            const unsigned rw[8] = {rv[0].x, rv[0].y, rv[0].z, rv[0].w, rv[1].x, rv[1].y, rv[1].z, rv[1].w};
#pragma unroll
            for (int j = 0; j < 16; ++j) { const int e = c0 + j; const unsigned v16 = (j & 1) ? (rw[j >> 1] >> 16) : (rw[j >> 1] & 0xffffu);
                *(PG8_LAS bf16_t*)(VT + e * 256 + (((lr >> 3) ^ (e & 15)) << 4) + (lr & 7) * 2) = (bf16_t)v16; }
            if (hf == 0) {
                conv_rows_load(proj, tok, spos, 1536 + h * 128 + cb + 16, rq);
                conv_rows_load(proj, tok, spos, 2048 + h * 128 + cb + 16, rk);
                const bf16_t* vs = proj + (size_t)tok * PROJ_LD + 2560 + h * 128 + cb + 16; rv[0] = *(const u32x4*)vs; rv[1] = *(const u32x4*)(vs + 8);
            }
        }
#pragma unroll
        for (int i = 0; i < 4; ++i) { const int q = tid + i * 512, row = q >> 4, ch = q & 15; *(PG8_LAS u32x4*)(CT + swz(row, ch)) = rc[i]; }
    }
    __syncthreads();
    {
        const int t = tid >> 2, part = tid & 3; float s = 0.f;
#pragma unroll
        for (int i = 0; i < 4; ++i) {
            const int ch = part * 4 + i;
            const u32x4 v = *(const PG8_LAS u32x4*)(Q + swz(t, ch));
            const PG8_LAS float* nn = n0s + ch * 8;
            s += bflo(v.x) * nn[0] + bfhi(v.x) * nn[1] + bflo(v.y) * nn[2] + bfhi(v.y) * nn[3] + bflo(v.z) * nn[4] + bfhi(v.z) * nn[5] + bflo(v.w) * nn[6] + bfhi(v.w) * nn[7];
        }
        s += shx(s, 1, lane); s += shx(s, 2, lane);
        if (part == 0) dq[t] = s;
    }
    const int t = 16 * w + fr;
    const float Mt = MA[t];
    bf16_t* orow = proj + (size_t)(tok0 + t) * PROJ_LD + 512 + h * 128 + fq * 4;
    u32x2 ovp[8];
#pragma unroll
    for (int nt = 0; nt < 8; ++nt) ovp[nt] = *(const u32x2*)(orow + nt * 16);
    f32x4 acc[8];
#pragma unroll
    for (int i = 0; i < 8; ++i) acc[i] = (f32x4){0.f, 0.f, 0.f, 0.f};
    strip_mma<8>(Q, 16 * w, KP, acc, lane, 0, 4, w + 1);
    float rowsum = 0.f;
    u32x2 pk[8];
#pragma unroll
    for (int nt = 0; nt < 8; ++nt) {
        float pv[4];
#pragma unroll
        for (int j = 0; j < 4; ++j) {
            const int s = nt * 16 + fq * 4 + j;
            const float wgt = (s <= t) ? __expf(gA[s] - Mt) : 0.f;
            pv[j] = (nt <= w) ? acc[nt][j] * wgt : 0.f;
            rowsum += pv[j];
        }
        pk[nt].x = cvt_pk_bf16(pv[0], pv[1]); pk[nt].y = cvt_pk_bf16(pv[2], pv[3]);
    }
    __syncthreads();
#pragma unroll
    for (int nt = 0; nt < 8; ++nt) *(PG8_LAS u32x2*)(KP + swz(t, nt * 2 + (fq >> 1)) + (fq & 1) * 8) = pk[nt];
    f32x4 acc2[8];
#pragma unroll
    for (int i = 0; i < 8; ++i) acc2[i] = (f32x4){0.f, 0.f, 0.f, 0.f};
    strip_mma<8>(Q, 16 * w, CT, acc2, lane, 0, 4, 8);
    const float iw = __expf(m0 - Mt);
#pragma unroll
    for (int i = 0; i < 8; ++i) acc2[i] = acc2[i] * iw;
    asm volatile("s_waitcnt lgkmcnt(0)" ::: "memory");
    strip_mma<8>(KP, 16 * w, VT, acc2, lane, 0, (16 * w + 15) / 32 + 1, 8);
    rowsum += shx(rowsum, 16, lane); rowsum += shx(rowsum, 32, lane);
    const float den = iw * dq[t] + rowsum;
    const float inv = 1.0f / fmaxf(fabsf(den), __expf(-(bA[t] + Mt)));
    float ss = 0.f;
#pragma unroll
    for (int nt = 0; nt < 8; ++nt) {
        const u32x2 ov = ovp[nt];
        acc2[nt][0] = acc2[nt][0] * inv * sigmoid_f(bflo(ov.x)); acc2[nt][1] = acc2[nt][1] * inv * sigmoid_f(bfhi(ov.x));
        acc2[nt][2] = acc2[nt][2] * inv * sigmoid_f(bflo(ov.y)); acc2[nt][3] = acc2[nt][3] * inv * sigmoid_f(bfhi(ov.y));
        ss += sum4(acc2[nt] * acc2[nt]);
    }
    ss += shx(ss, 16, lane); ss += shx(ss, 32, lane);
    const float rn = rsqrtf(ss * (1.0f / 128.0f) + EPS);
    const PG8_LAS float* ng = wts + 1280 + fq * 4;
#pragma unroll
    for (int nt = 0; nt < 8; ++nt) {
        const f32x4 gv = *(const PG8_LAS f32x4*)(ng + nt * 16);
        u32x2 o; o.x = cvt_pk_bf16(acc2[nt][0] * rn * gv[0], acc2[nt][1] * rn * gv[1]); o.y = cvt_pk_bf16(acc2[nt][2] * rn * gv[2], acc2[nt][3] * rn * gv[3]);
        if (!dry) *(u32x2*)(orow + nt * 16) = o;
    }
    __syncthreads();
}

__device__ __forceinline__ void actfix_phase(KP p, int l) {
    const float* __restrict__ halo = (const float*)(p->ws + WS_HALO); bf16_t* __restrict__ act = (bf16_t*)(p->ws + WS_ACT);
    const float* cw = p->in[16] + (size_t)l * 3 * UPN; const float* cb = p->in[17] + (size_t)l * UPN;
    const int nitems = 512 * 2 * (DFF / 4);
    for (int it = obid() * 512 + otid(); it < nitems; it += gridDim.x * 512) {
        const int g = it % (DFF / 4), br = it / (DFF / 4), rr = br & 1, blk = br >> 1, ch = g * 4;
        const bool seqstart = (blk & 255) == 0;
        const f32x4 z = (f32x4){0.f, 0.f, 0.f, 0.f};
        const float* cur = halo + (size_t)(blk * 4 + rr) * UPN + ch;
        const float* pt = halo + (size_t)((blk - 1) * 4 + 2) * UPN + ch;
        const f32x4 xa = *(const f32x4*)cur, xb = *(const f32x4*)(cur + DFF);
        f32x4 p1a, p1b, p2a, p2b;
        if (rr == 0) {
            p1a = seqstart ? z : *(const f32x4*)(pt + UPN); p1b = seqstart ? z : *(const f32x4*)(pt + UPN + DFF);
            p2a = seqstart ? z : *(const f32x4*)pt;         p2b = seqstart ? z : *(const f32x4*)(pt + DFF);
        } else {
            p1a = *(const f32x4*)(cur - UPN); p1b = *(const f32x4*)(cur - UPN + DFF);
            p2a = seqstart ? z : *(const f32x4*)(pt + UPN); p2b = seqstart ? z : *(const f32x4*)(pt + UPN + DFF);
        }
        const f32x4 wa0 = *(const f32x4*)(cw + ch), wa1 = *(const f32x4*)(cw + UPN + ch), wa2 = *(const f32x4*)(cw + 2 * UPN + ch), ba = *(const f32x4*)(cb + ch);
        const f32x4 wb0 = *(const f32x4*)(cw + DFF + ch), wb1 = *(const f32x4*)(cw + UPN + DFF + ch), wb2 = *(const f32x4*)(cw + 2 * UPN + DFF + ch), bb = *(const f32x4*)(cb + DFF + ch);
        const f32x4 ca = ba + wa0 * p2a + wa1 * p1a + wa2 * xa, cbv = bb + wb0 * p2b + wb1 * p1b + wb2 * xb;
        u32x2 o; o.x = cvt_pk_bf16(silu_f(ca[0]) * cbv[0], silu_f(ca[1]) * cbv[1]); o.y = cvt_pk_bf16(silu_f(ca[2]) * cbv[2], silu_f(ca[3]) * cbv[3]);
        *(u32x2*)(act + (size_t)(blk * 64 + rr) * DFF + ch) = o;
    }
}

__device__ __forceinline__ void pconv_phase(KP p, int l) {
    const float* __restrict__ src = p->in[1] + (size_t)l * NTOK * 256; bf16_t* __restrict__ dst = (bf16_t*)(p->ws + WS_PBF);
    const int nitems = NTOK * 256 / 8, stride = gridDim.x * 512;
    for (int i0 = obid() * 512 + otid(); i0 < nitems; i0 += stride * 4) {
        f32x4 a[4], b[4];
#pragma unroll
        for (int u = 0; u < 4; ++u) { const int i = i0 + u * stride < nitems ? i0 + u * stride : i0; a[u] = *(const f32x4*)(src + (size_t)i * 8); b[u] = *(const f32x4*)(src + (size_t)i * 8 + 4); }
#pragma unroll
        for (int u = 0; u < 4; ++u) { const int i = i0 + u * stride;
            if (i < nitems) { u32x4 wv; wv.x = cvt_pk_bf16(a[u][0], a[u][1]); wv.y = cvt_pk_bf16(a[u][2], a[u][3]); wv.z = cvt_pk_bf16(b[u][0], b[u][1]); wv.w = cvt_pk_bf16(b[u][2], b[u][3]); *(u32x4*)(dst + (size_t)i * 8) = wv; } }
    }
}

__device__ __forceinline__ void final_phase(KP p, const float* ssq) {
    const int tid = otid(), lane = tid & 63, w = __builtin_amdgcn_readfirstlane(tid >> 6);
    f32x4 g[4];
#pragma unroll
    for (int i = 0; i < 4; ++i) g[i] = *(const f32x4*)(p->in[22] + i * 256 + lane * 4);
    for (int rowb = obid() * 8 + w; rowb < NTOK; rowb += gridDim.x * 8 * 4) {
        const int rstep = gridDim.x * 8;
        f32x4 xv[4][4]; float rr[4];
#pragma unroll
        for (int u = 0; u < 4; ++u) { const int row = rowb + u * rstep < NTOK ? rowb + u * rstep : rowb; rr[u] = rowscale(ssq, row);
#pragma unroll
            for (int i = 0; i < 4; ++i) xv[u][i] = *(const f32x4*)(p->out + (size_t)row * DM + i * 256 + lane * 4); }
#pragma unroll
        for (int u = 0; u < 4; ++u) { const int row = rowb + u * rstep;
            if (row < NTOK) {
#pragma unroll
                for (int i = 0; i < 4; ++i) *(f32x4*)(p->out + (size_t)row * DM + i * 256 + lane * 4) = xv[u][i] * rr[u] * g[i];
            } }
    }
}

#ifndef PROBE_STAGE
#define PROBE_STAGE 0
#endif
__device__ __forceinline__ void dump_phase(KP p) {
    const bf16_t* proj = (const bf16_t*)(p->ws + WS_PROJ); const float* gates = (const float*)(p->ws + WS_GATES); const float* lnstat = (const float*)(p->ws + WS_LNSTAT);
    const bf16_t* dc = (const bf16_t*)(p->ws + WS_DC); const float* dn = (const float*)(p->ws + WS_DN); const float* chs = (const float*)(p->ws + WS_CHBL);
    for (int i = obid() * 512 + otid(); i < NTOK * DM; i += gridDim.x * 512) {
        const int row = i >> 10, c = i & 1023;
        float v = bf2f(proj[(size_t)row * PROJ_LD + c]) + bf2f(proj[(size_t)row * PROJ_LD + 1024 + c]) + bf2f(proj[(size_t)row * PROJ_LD + 2048 + c]) + gates[(size_t)row * 8 + (c & 7)] + lnstat[(size_t)row * 16 + (c & 15)];
        if (PROBE_STAGE >= 2) v += bf2f(dc[i & (8 * 128 * 16384 - 1)]) + dn[i & 131071] + chs[i & 2047];
        if (PROBE_STAGE >= 3) v += chs[2048 + (i & 1023)];
        p->out[i] = v;
    }
}
#define PROBE_AT(s) do { if (PROBE_STAGE == (s)) { if ((s) <= 4) dump_phase(p); return; } } while (0)
#define XB_TMO      128
#define XB_XCNT(j)  (256  + 64 * (j))
#define XB_XSUB(j)  (1280 + 64 * (j))
#define XB_XGEN(j)  (2304 + 64 * (j))
#define XB_TOP      3328
#define XB_TOPGEN   3392
#define XCD_BAR_WORDS 3456
#define XB_SPIN_CAP (1u << 18)

__device__ __forceinline__ unsigned xb_ld(unsigned* p)              { return __hip_atomic_load(p, __ATOMIC_RELAXED, __HIP_MEMORY_SCOPE_AGENT); }
__device__ __forceinline__ unsigned xb_add(unsigned* p, unsigned v) { return __hip_atomic_fetch_add(p, v, __ATOMIC_RELAXED, __HIP_MEMORY_SCOPE_AGENT); }
__device__ __forceinline__ unsigned xb_xcc_id() { return (unsigned)__builtin_amdgcn_s_getreg((3 << 11) | 20) & 0xFu; }
#define XB_SPIN(cond, bar) do { unsigned _sp = 0; while (cond) { __builtin_amdgcn_s_sleep(1); \
    if ((++_sp & 255u) == 0u) { if (xb_ld(&(bar)[XB_TMO])) break; if (_sp > XB_SPIN_CAP) { atomicAdd(&(bar)[XB_TMO], 1u); break; } } } } while (0)

struct XcdBarrier {
    unsigned* bar; unsigned x;
    volatile PG8_LAS unsigned* st;
};

__device__ __forceinline__ XcdBarrier xcd_barrier_post(unsigned* bar, volatile PG8_LAS unsigned* st) {
    XcdBarrier b; b.bar = bar; b.x = xb_xcc_id(); b.st = st;
    if (otid() == 0) (void)xb_add(&bar[XB_XCNT(b.x)], 1u);
    return b;
}
__device__ __forceinline__ void xcd_barrier_complete(unsigned* bar, unsigned x, unsigned& nloc, unsigned& nx) {
    const unsigned G = gridDim.x * gridDim.y * gridDim.z;
    unsigned sum, cnt, mine, sp = 0u;
    for (;;) {
        sum = 0u; cnt = 0u; mine = 0u;
#pragma unroll
        for (unsigned j = 0; j < 16; ++j) { const unsigned c = xb_ld(&bar[XB_XCNT(j)]); sum += c; cnt += (c > 0u) ? 1u : 0u; mine = (j == x) ? c : mine; }
        if (sum == G) break;
        __builtin_amdgcn_s_sleep(1);
        if ((++sp & 255u) == 0u) { if (xb_ld(&bar[XB_TMO])) break; if (sp > XB_SPIN_CAP) { atomicAdd(&bar[XB_TMO], 1u); break; } }
    }
    nloc = mine > 0u ? mine : 1u; nx = cnt > 0u ? cnt : 1u;
}

__device__ __forceinline__ void xcd_barrier(const XcdBarrier& b) {
    asm volatile("s_waitcnt vmcnt(0)" ::: "memory");
    __syncthreads();
    if (otid() == 0) {
        unsigned* bar = b.bar;
        __builtin_amdgcn_s_waitcnt(0);
        unsigned nloc = b.st[0], nx = b.st[1];
        if (nloc == 0u) { xcd_barrier_complete(bar, b.x, nloc, nx); b.st[0] = nloc; b.st[1] = nx; }
        const unsigned old = xb_add(&bar[XB_XSUB(b.x)], 1u);
        const unsigned gen = old / nloc;
        if (old + 1u == (gen + 1u) * nloc) {
            __builtin_amdgcn_fence(__ATOMIC_RELEASE, "agent");
            asm volatile("s_waitcnt vmcnt(0)" ::: "memory");
            const unsigned og = xb_add(&bar[XB_TOP], 1u);
            const unsigned tg = og / nx;
            if (og + 1u == (tg + 1u) * nx) xb_add(&bar[XB_TOPGEN], 1u);
            else XB_SPIN(xb_ld(&bar[XB_TOPGEN]) == tg, bar);
            __builtin_amdgcn_fence(__ATOMIC_ACQUIRE, "agent");
            xb_add(&bar[XB_XGEN(b.x)], 1u);
            asm volatile("s_waitcnt vmcnt(0)" ::: "memory");
        } else {
            XB_SPIN(xb_ld(&bar[XB_XGEN(b.x)]) == gen, bar);
            __builtin_amdgcn_fence(__ATOMIC_ACQUIRE, "agent");
            asm volatile("s_waitcnt vmcnt(0)" ::: "memory");
        }
    }
    __syncthreads();
}


#define GSYNC() do { asm volatile("s_waitcnt vmcnt(0)" ::: "memory"); grid.sync(); } while (0)
#define XSYNC() do { XcdBarrier t_; t_.bar = (unsigned*)(p->ws + WS_BAR); t_.x = xb_x; t_.st = xst; asm volatile("" : "+s"(t_.x)); xcd_barrier(t_); } while (0)
__global__ void __launch_bounds__(512, 2) fwd_kernel(Params p_arg) {
    KP kp0 = (KP)__builtin_amdgcn_kernarg_segment_ptr(); (void)p_arg;
#define p okp(kp0)
    extern __shared__ __attribute__((aligned(16))) unsigned char shm[];
    ldsp lds = (ldsp)shm;
    cg::grid_group grid = cg::this_grid();
    unsigned char* ws = p->ws;
    volatile PG8_LAS unsigned* xst = (volatile PG8_LAS unsigned*)(lds + 131072 + 1024 + 8192);
    if (threadIdx.x < 4) xst[threadIdx.x] = 0u;
    __syncthreads();
    const unsigned xb_x = __builtin_amdgcn_readfirstlane(xcd_barrier_post((unsigned*)(ws + WS_BAR), xst).x);
    prep_phase(lds, p);
#ifdef REP_PREP
    prep_phase(lds, p);
#endif
    if (p->ws == nullptr) GSYNC();
    XSYNC();
    int cur = 0;
#pragma unroll 1
    for (int l = 0; l < DEPTH; ++l) {
        bf16_t* xb_c = (bf16_t*)(ws + (cur ? WS_XB1 : WS_XB0)); bf16_t* xb_n = (bf16_t*)(ws + (cur ? WS_XB0 : WS_XB1));
        float* ssq_c = (float*)(ws + (cur ? WS_SSQ1 : WS_SSQ0)); float* ssq_n = (float*)(ws + (cur ? WS_SSQ0 : WS_SSQ1));
        const unsigned char* wt = ws + WS_WT + (size_t)l * WT_LAYER;
        bf16_t* proj = (bf16_t*)(ws + WS_PROJ);
#ifdef REP_A
        gates_phase(lds, p, l, xb_c, ssq_c, 2);
        { EpiProj E; E.rl = (PG8_LAS float*)(lds + 131072); E.proj = proj; E.ssq = ssq_c; E.lnstat = (float*)(ws + WS_LNSTAT); run_gemm(lds, xb_c, DM, (const bf16_t*)(wt + WT_IN), NTOK, 3072, 1024, E); }
#endif
        if (obid() & 1) gates_phase(lds, p, l, xb_c, ssq_c, 2);
        { EpiProj E; E.rl = (PG8_LAS float*)(lds + 131072); E.proj = proj; E.ssq = ssq_c; E.lnstat = (float*)(ws + WS_LNSTAT); run_gemm(lds, xb_c, DM, (const bf16_t*)(wt + WT_IN), NTOK, 3072, 1024, E); }
        if (!(obid() & 1)) gates_phase(lds, p, l, xb_c, ssq_c, 2);
        XSYNC();
        PROBE_AT(1);
#ifdef REP_GM
        for (int t = obid(); t < 2048; t += gridDim.x) gmlp_task(lds, p, l, t, true);
#endif
#ifdef REP_DC
        mlstm_dc_all(lds, p, l);
#endif
#ifdef REP_SYNC
        for (int q = 0; q < 10; ++q) XSYNC();
#endif
        mlstm_dc_all(lds, p, l);
        for (int t = obid(); t < 3072; t += gridDim.x) {

#if !defined(PROBE_B_ONLY) || PROBE_B_ONLY == 2
            if (t >= 1024) gmlp_task(lds, p, l, t - 1024);
#endif
        }
        XSYNC();
        PROBE_AT(2);
#ifdef REP_C
        scan_phase(p, true);
#endif
        scan_phase(p);
        XSYNC();
        PROBE_AT(3);
#ifdef REP_D
        for (int t = obid(); t < 1024; t += gridDim.x) mlstm_out_task(lds, p, l, t, true);
#endif
        for (int t = obid(); t < 1024; t += gridDim.x) mlstm_out_task(lds, p, l, t);
        XSYNC();
        PROBE_AT(4);
#ifdef REP_E0
        if (l == 0) { EpiResid E; E.dry = 0; E.xin = p->in[0]; E.xout = p->out; E.xb = xb_n; E.ssq = ssq_n; E.row_off = 0; run_gemm(lds, proj, PROJ_LD, (const bf16_t*)(wt + WT_OUT), NTOK, 1024, 1024, E); }
#endif
        { EpiResid E; E.dry = 0; E.xin = l == 0 ? p->in[0] : p->out; E.xout = p->out; E.xb = xb_n; E.ssq = ssq_n; E.row_off = 0; run_gemm(lds, proj, PROJ_LD, (const bf16_t*)(wt + WT_OUT), NTOK, 1024, 1024, E); }
        XSYNC();
        PROBE_AT(5);
        { EpiUpAct E; E.rl = (PG8_LAS float*)(lds + 131072); E.act = (bf16_t*)(ws + WS_ACT); E.halo = (float*)(ws + WS_HALO); E.ssq = ssq_n; E.cw = p->in[16] + (size_t)l * 3 * UPN; E.cb = p->in[17] + (size_t)l * UPN;
          run_gemm(lds, xb_n, DM, (const bf16_t*)(wt + WT_UP), NTOK, UPN, 1024, E);
#ifdef REP_F
          run_gemm(lds, xb_n, DM, (const bf16_t*)(wt + WT_UP), NTOK, UPN, 1024, E);
#endif
        }
        XSYNC();
#ifdef REP_G
        actfix_phase(p, l);
#endif
        actfix_phase(p, l);
        XSYNC();
#ifdef REP_PCONV
        pconv_phase(p, l);
#endif
#ifdef REP_H
        { EpiResid E; E.dry = 1; E.xin = p->out; E.xout = p->out; E.xb = xb_c; E.ssq = ssq_c; E.row_off = 0; run_gemm(lds, (const bf16_t*)(ws + WS_ACT), DFF, (const bf16_t*)(wt + WT_DOWN), NTOK, 1024, DFF, E); }
#endif
        if (obid() & 1) pconv_phase(p, l);
        { EpiResid E; E.dry = 0; E.xin = p->out; E.xout = p->out; E.xb = xb_c; E.ssq = ssq_c; E.row_off = 0; run_gemm(lds, (const bf16_t*)(ws + WS_ACT), DFF, (const bf16_t*)(wt + WT_DOWN), NTOK, 1024, DFF, E); }
        if (!(obid() & 1)) pconv_phase(p, l);
        XSYNC();
        PROBE_AT(6);
#ifdef REP_PE
        { EpiPe E; E.pe = (bf16_t*)(ws + WS_PE); run_gemm(lds, (const bf16_t*)(ws + WS_PBF), 256, (const bf16_t*)(wt + WT_PLE), NTOK, 1024, 256, E); }
#endif
        { EpiPe E; E.pe = (bf16_t*)(ws + WS_PE); run_gemm(lds, (const bf16_t*)(ws + WS_PBF), 256, (const bf16_t*)(wt + WT_PLE), NTOK, 1024, 256, E); }
#ifdef REP_GATE
        { EpiGate E; E.dry = 1; E.rl = (PG8_LAS float*)(lds + 131072); E.x = p->out; E.pe = (const bf16_t*)(ws + WS_PE); E.ssq_in = ssq_c; E.xb = xb_n; E.ssq = ssq_n; run_gemm(lds, xb_c, DM, (const bf16_t*)(wt + WT_GATE), NTOK, 1024, 1024, E); }
#endif
        { EpiGate E; E.dry = 0; E.rl = (PG8_LAS float*)(lds + 131072); E.x = p->out; E.pe = (const bf16_t*)(ws + WS_PE); E.ssq_in = ssq_c; E.xb = xb_n; E.ssq = ssq_n; run_gemm(lds, xb_c, DM, (const bf16_t*)(wt + WT_GATE), NTOK, 1024, 1024, E); }
        XSYNC();
        PROBE_AT(7);
        cur ^= 1;
    }
    final_phase(p, (const float*)(ws + (cur ? WS_SSQ1 : WS_SSQ0)));
}

#undef p
extern "C" void kernel_launch(void* const* d_in, const int* in_sizes, int n_in, void* d_out, int out_size, void* d_ws, size_t ws_size, hipStream_t stream) {
    static int grid_blocks = 0;
    if (grid_blocks == 0) {
        if (n_in != 23 || ws_size < WS_END) { fprintf(stderr, "kernel_launch: unexpected n_in %d / ws_size %zu (need %zu)\n", n_in, ws_size, (size_t)WS_END); grid_blocks = -1; return; }
        int dev = 0, cus = 0, per_cu = 0;
        hipGetDevice(&dev);
        hipDeviceGetAttribute(&cus, hipDeviceAttributeMultiprocessorCount, dev);
        if (hipFuncSetAttribute((const void*)fwd_kernel, hipFuncAttributeMaxDynamicSharedMemorySize, LDS_BYTES) != hipSuccess) { fprintf(stderr, "kernel_launch: hipFuncSetAttribute failed\n"); grid_blocks = -1; return; }
        if (hipOccupancyMaxActiveBlocksPerMultiprocessor(&per_cu, (const void*)fwd_kernel, 512, LDS_BYTES) != hipSuccess || per_cu < 1) { fprintf(stderr, "kernel_launch: occupancy query failed (%d)\n", per_cu); per_cu = 1; (void)hipGetLastError(); }
        grid_blocks = cus * per_cu;
        if (grid_blocks > 256) grid_blocks = 256;
    }
    if (grid_blocks < 0) return;
    if (hipMemsetAsync((char*)d_ws + WS_BAR, 0, XCD_BAR_WORDS * sizeof(unsigned), stream) != hipSuccess) { fprintf(stderr, "kernel_launch: memset of the barrier words failed\n"); return; }
    Params p{};
    for (int i = 0; i < 23; ++i) p.in[i] = (const float*)d_in[i];
    p.out = (float*)d_out; p.ws = (unsigned char*)d_ws;
    void* args[] = {&p};
    hipError_t e = hipLaunchCooperativeKernel((const void*)fwd_kernel, dim3(grid_blocks), dim3(512), args, LDS_BYTES, stream);
    if (e != hipSuccess) fprintf(stderr, "cooperative launch failed: %s (grid %d)\n", hipGetErrorString(e), grid_blocks);
}
```

```cpp
#include <hip/hip_runtime.h>
#include <hip/hip_cooperative_groups.h>
#include <cstdio>
namespace cg = cooperative_groups;
namespace pg8 {
#define PG8_LAS __attribute__((address_space(3)))
typedef unsigned short bf16_t;
typedef short bf16x8 __attribute__((ext_vector_type(8)));
typedef float f32x4 __attribute__((ext_vector_type(4)));
typedef unsigned u32x4 __attribute__((ext_vector_type(4)));
constexpr int BM = 256, BK = 64, HALF = 128, HTB = HALF * BK * 2  , STAGE_BYTES = 8 * HTB, NXCD = 8, WGM = 8;

__host__ __device__ __forceinline__ int lds_byte(int r, int c) { const int st = (r >> 4) * 2 + (c >> 5), rr = r & 15, cc = c & 31, ob = rr * 64 + cc * 2; return st * 1024 + (ob ^ (((ob >> 9) & 1) << 5)); }
__host__ __device__ __forceinline__ void stage_rc(int b, int& R, int& C) { const int st = b / 1024, sb = b % 1024, swz = sb ^ (((sb >> 9) & 1) << 5); R = (st >> 1) * 16 + swz / 64; C = (st & 1) * 32 + (swz % 64) / 2; }
__host__ __device__ __forceinline__ int perm32(int rho) { const int n = rho >> 4, i = rho & 15; return 8 * (i >> 2) + 4 * n + (i & 3); }
__device__ __forceinline__ int otid() { int t = (int)threadIdx.x; asm volatile("" : "+v"(t)); return t; }
__device__ __forceinline__ int obid() { int t = (int)blockIdx.x; asm volatile("" : "+s"(t)); return t; }
struct Unit { int pm, pn; };
struct Gemm { const bf16_t* A; const bf16_t* Bt; int M, N, K, lda; };

struct StaticOrder {
    int nM, nN, nwg, G, c;
    __host__ __device__ void init(int M, int N, int G_, int c_) { nM = M / BM; nN = N / BM; nwg = nM * nN; G = G_; c = c_; }
    __host__ __device__ bool next(int i, Unit& u) const {
        const long L = (long)i * G + c; if (L >= nwg) return false;
        int wgid = (int)L; { const int q = nwg / NXCD, r = nwg % NXCD, xcd = wgid % NXCD, off = wgid / NXCD; wgid = (xcd < r ? xcd * (q + 1) : r * (q + 1) + (xcd - r) * q) + off; }
        const int nig = WGM * nN, gid = wgid / nig, fm = gid * WGM, gsz = (nM - fm) < WGM ? (nM - fm) : WGM;
        u.pm = fm + ((wgid % nig) % gsz); u.pn = (wgid % nig) / gsz; return true;
    }
    __device__ __forceinline__ void a_ready(const Unit&) const {}
    __device__ __forceinline__ void done(const Unit&) const {}
};
__device__ __forceinline__ unsigned cvt_pk_bf16(float lo, float hi) { typedef __bf16 bf2_t __attribute__((ext_vector_type(2))); typedef float f2_t __attribute__((ext_vector_type(2))); const bf2_t r = __builtin_convertvector((f2_t){lo, hi}, bf2_t); return __builtin_bit_cast(unsigned, r); }
typedef float f32x2 __attribute__((ext_vector_type(2)));
__device__ __forceinline__ f32x2 gelu_pk(f32x2 v) {
    const f32x2 av = __builtin_elementwise_abs(v), d = av * 0.2316418882f + 1.0f;
    f32x2 t; t.x = __builtin_amdgcn_rcpf(d.x); t.y = __builtin_amdgcn_rcpf(d.y);
    f32x2 q = t * 0.5307027145f + (-0.7265760135f); q = q * t + 0.7107068705f; q = q * t + (-0.142248368f); q = q * t + 0.127414796f; q = q * t;
    const f32x2 s = (v * v) * (-0.72134752044f);
    f32x2 e; e.x = __builtin_amdgcn_exp2f(s.x); e.y = __builtin_amdgcn_exp2f(s.y);
    const f32x2 m = v * (q * e), r = v - m;
    f32x2 o; o.x = v.x < 0.f ? m.x : r.x; o.y = v.y < 0.f ? m.y : r.y; return o;
}

template <class Epi, class Sched>
__device__ __forceinline__ void gemm_phase(PG8_LAS unsigned char* lds, const Gemm g, const Sched& S, const Epi& E) {
    const int tid = otid(), wid = __builtin_amdgcn_readfirstlane(tid >> 6), lane = tid & 63, wr = wid >> 2, wc = wid & 3, fr = lane & 15, fq = lane >> 4;
    const int K = g.K, nt = K / BK;
    unsigned voffA[2], voffB[2];
#pragma unroll
    for (int i = 0; i < 2; ++i) { int R, C; stage_rc(tid * 16 + i * 8192, R, C); const int Rb = Epi::PERM ? ((R & ~31) + perm32(R & 31)) : R;
        const int Ra = Epi::APERM ? ((R & ~63) + 4 * (R & 15) + ((R >> 4) & 3)) : R;
        voffA[i] = (unsigned)(Ra * g.lda + C) * 2u; voffB[i] = (unsigned)(Rb * K + C) * 2u; }
    const size_t kstep = (size_t)(BK * 2);
    const size_t hstepB = (size_t)HALF * K * 2, hstepA = (size_t)HALF * g.lda * 2;
    const size_t tstepB = 2 * hstepB, tstepA = 2 * hstepA;
    const unsigned ldsw = (unsigned)wid * 1024u;
    const int aoff = lds_byte(wr * 64 + fr, fq * 8), boff = lds_byte(wc * 32 + fr, fq * 8);
#define PG8_SA(b, h) (((b) * 2 + (h)) * HTB)
#define PG8_SB(b, h) ((4 + (b) * 2 + (h)) * HTB)
#define PG8_STAGE(bufoff, gbase, voff) do { _Pragma("unroll") for (int _i = 0; _i < 2; ++_i) \
        __builtin_amdgcn_global_load_lds((const unsigned*)((const char*)(gbase) + (voff)[_i]), (PG8_LAS unsigned*)(lds + (bufoff) + ldsw + _i * 8192), 16, 0, 0); } while (0)
#define PG8_LDA(dst, b, h) do { _Pragma("unroll") for (int m = 0; m < 4; ++m) _Pragma("unroll") for (int k = 0; k < 2; ++k) dst[m][k] = *(const PG8_LAS bf16x8*)(lds + PG8_SA(b, h) + aoff + m * 2048 + k * 1024); } while (0)
#define PG8_LDB(dst, b, h) do { _Pragma("unroll") for (int n = 0; n < 2; ++n) _Pragma("unroll") for (int k = 0; k < 2; ++k) dst[n][k] = *(const PG8_LAS bf16x8*)(lds + PG8_SB(b, h) + boff + n * 2048 + k * 1024); } while (0)
#define PG8_MMA(ai, bj, At, Bt) do { __builtin_amdgcn_s_setprio(1); _Pragma("unroll") for (int m = 0; m < 4; ++m) _Pragma("unroll") for (int n = 0; n < 2; ++n) _Pragma("unroll") for (int k = 0; k < 2; ++k) \
        acc[ai][bj][m][n] = __builtin_amdgcn_mfma_f32_16x16x32_bf16(Bt[n][k], At[m][k], acc[ai][bj][m][n], 0, 0, 0); __builtin_amdgcn_s_setprio(0); } while (0)
#define PG8_WAIT_V(n) asm volatile("s_waitcnt vmcnt(" #n ")" ::: "memory")
#define PG8_WAIT_L(n) asm volatile("s_waitcnt lgkmcnt(" #n ")" ::: "memory")
#define PG8_BAR __builtin_amdgcn_s_barrier()
#define PG8_SCHED __builtin_amdgcn_sched_barrier(0)
    Unit cur, nxt; int ui = 0;
    if (!S.next(0, cur)) return;
    f32x4 acc[2][2][4][2];
#pragma unroll
    for (int a = 0; a < 2; ++a)
#pragma unroll
        for (int b = 0; b < 2; ++b)
#pragma unroll
            for (int m = 0; m < 4; ++m)
#pragma unroll
                for (int n = 0; n < 2; ++n) acc[a][b][m][n] = (f32x4){0.f, 0.f, 0.f, 0.f};
    bf16x8 At[4][2], B0[2][2], B1[2][2];
    const char* cA = (const char*)g.A + (size_t)cur.pm * tstepA; const char* cB = (const char*)g.Bt + (size_t)cur.pn * tstepB;
    S.a_ready(cur);
    PG8_STAGE(PG8_SB(0, 0), cB, voffB); PG8_STAGE(PG8_SA(0, 0), cA, voffA); PG8_STAGE(PG8_SB(0, 1), cB + hstepB, voffB); PG8_STAGE(PG8_SA(0, 1), cA + hstepA, voffA);
    if (wr == 1) PG8_BAR;
    PG8_WAIT_V(4); PG8_BAR;
    PG8_STAGE(PG8_SB(1, 0), cB + kstep, voffB); PG8_STAGE(PG8_SA(1, 0), cA + kstep, voffA); PG8_STAGE(PG8_SB(1, 1), cB + hstepB + kstep, voffB);
    PG8_WAIT_V(6); PG8_BAR;
    for (;;) {
        const bool has_next = S.next(ui + 1, nxt);
        const char* nA = has_next ? (const char*)g.A + (size_t)nxt.pm * tstepA : cA; const char* nB = has_next ? (const char*)g.Bt + (size_t)nxt.pn * tstepB : cB;
        for (int t = 0; t < nt; t += 2) {
            const bool last = (t == nt - 2);
            const char* a1 = cA + (size_t)(t + 1) * kstep;
            const char* a2 = last ? nA : cA + (size_t)(t + 2) * kstep; const char* b2 = last ? nB : cB + (size_t)(t + 2) * kstep;
            const char* a3 = a2 + kstep; const char* b3 = b2 + kstep;
            if (last && has_next) S.a_ready(nxt);
            PG8_LDB(B0, 0, 0); PG8_SCHED; PG8_LDA(At, 0, 0); PG8_STAGE(PG8_SA(1, 1), a1 + hstepA, voffA);
            PG8_WAIT_L(8); PG8_BAR; PG8_WAIT_L(0); PG8_MMA(0, 0, At, B0); PG8_BAR; PG8_SCHED;
            PG8_LDB(B1, 0, 1); PG8_STAGE(PG8_SB(0, 0), b2, voffB);
            PG8_BAR; PG8_WAIT_L(0); PG8_MMA(0, 1, At, B1); PG8_BAR;
            PG8_LDA(At, 0, 1); PG8_STAGE(PG8_SA(0, 0), a2, voffA);
            PG8_BAR; PG8_WAIT_L(0); PG8_MMA(1, 0, At, B0); PG8_BAR; PG8_SCHED;
            PG8_STAGE(PG8_SB(0, 1), b2 + hstepB, voffB);
            PG8_WAIT_V(6); PG8_BAR; PG8_MMA(1, 1, At, B1); PG8_BAR;
            PG8_LDB(B0, 1, 0); PG8_SCHED; PG8_LDA(At, 1, 0); PG8_STAGE(PG8_SA(0, 1), a2 + hstepA, voffA);
            PG8_WAIT_L(8); PG8_BAR; PG8_WAIT_L(0); PG8_MMA(0, 0, At, B0); PG8_BAR; PG8_SCHED;
            PG8_LDB(B1, 1, 1); PG8_STAGE(PG8_SB(1, 0), b3, voffB);
            PG8_BAR; PG8_WAIT_L(0); PG8_MMA(0, 1, At, B1); PG8_BAR;
            PG8_LDA(At, 1, 1); PG8_STAGE(PG8_SA(1, 0), a3, voffA);
            PG8_BAR; PG8_WAIT_L(0); PG8_MMA(1, 0, At, B0); PG8_BAR; PG8_SCHED;
            PG8_STAGE(PG8_SB(1, 1), b3 + hstepB, voffB);
            PG8_WAIT_V(6); PG8_BAR; PG8_MMA(1, 1, At, B1); PG8_BAR;
        }
        if constexpr (!Epi::AFTER_DRAIN) { E(acc, cur, wr, wc, fr, fq); S.done(cur); }
        if (!has_next) break;
#pragma unroll
        for (int a = 0; a < 2; ++a)
#pragma unroll
            for (int b = 0; b < 2; ++b)
#pragma unroll
                for (int m = 0; m < 4; ++m)
#pragma unroll
                    for (int n = 0; n < 2; ++n) acc[a][b][m][n] = (f32x4){0.f, 0.f, 0.f, 0.f};
        cur = nxt; cA = nA; cB = nB; ++ui;
    }
    PG8_WAIT_V(0);
    if (wr == 0) PG8_BAR;
    PG8_BAR;
    if constexpr (Epi::AFTER_DRAIN) { E.fused(acc, cur, wr, wc, fr, fq, lds, wid, lane); S.done(cur); }
#undef PG8_SA
#undef PG8_SB
#undef PG8_STAGE
#undef PG8_LDA
#undef PG8_LDB
#undef PG8_MMA
#undef PG8_WAIT_V
#undef PG8_WAIT_L
#undef PG8_BAR
#undef PG8_SCHED
}
}

using pg8::otid; using pg8::obid; using pg8::bf16_t; using pg8::bf16x8; using pg8::f32x4; using pg8::u32x4; using pg8::f32x2; using pg8::cvt_pk_bf16; using pg8::gelu_pk;
typedef unsigned u32x2 __attribute__((ext_vector_type(2)));
typedef PG8_LAS unsigned char* ldsp;

constexpr int NTOK = 32768, SEQ = 16384, DM = 1024, DEPTH = 4, PROJ_LD = 3072, DFF = 2816, UPN = 5632;
constexpr float EPS = 1e-6f;
constexpr int LDS_BYTES = 131072 + 1024 + 8192 + 16;
constexpr size_t MiB = 1ull << 20;
constexpr size_t WS_XB0 = 0, WS_XB1 = 64 * MiB, WS_WT = 128 * MiB;
constexpr size_t WT_IN = 0, WT_OUT = 6291456, WT_UP = 8388608, WT_DOWN = 19922944, WT_GATE = 25690112, WT_PLE = 27787264, WT_WSB = 28311552, WT_LAYER = 28573696;
constexpr size_t WS_SMALL = 237 * MiB;
constexpr size_t WS_SSQ0 = WS_SMALL, WS_SSQ1 = WS_SMALL + 2 * MiB, WS_LNSTAT = WS_SMALL + 4 * MiB, WS_GATES = WS_SMALL + 6 * MiB, WS_DN = WS_SMALL + 7 * MiB;
constexpr size_t WS_CHBL = WS_SMALL + 7 * MiB + 512 * 1024, WS_CHAMAX = WS_CHBL + 4096, WS_CHM0 = WS_CHBL + 8192, WS_WG = WS_CHBL + 65536, WS_BAR = WS_CHBL + 65536 + 131072;
constexpr size_t WS_R = 245 * MiB;
constexpr size_t WS_PROJ = WS_R, WS_DC = WS_R + 192 * MiB, WS_ACT = WS_R, WS_HALO = WS_R + 176 * MiB, WS_PBF = WS_R + 176 * MiB, WS_PE = WS_R;
constexpr size_t WS_END = WS_R + 264 * MiB;

struct Params { const float* in[23]; float* out; unsigned char* ws; };
typedef const Params __attribute__((address_space(4)))* KP;
__device__ __forceinline__ KP okp(KP p) { asm volatile("" : "+s"(p)); return p; }

__device__ __forceinline__ float bflo(unsigned w) { return __uint_as_float(w << 16); }
__device__ __forceinline__ float bfhi(unsigned w) { return __uint_as_float(w & 0xffff0000u); }
__device__ __forceinline__ bf16_t f2bf(float f) { return (bf16_t)(cvt_pk_bf16(f, 0.f) & 0xffffu); }
__device__ __forceinline__ float bf2f(bf16_t b) { return __uint_as_float(((unsigned)b) << 16); }
__device__ __forceinline__ float sigmoid_f(float x) { return __builtin_amdgcn_rcpf(1.f + __builtin_amdgcn_exp2f(x * -1.4426950408889634f)); }
__device__ __forceinline__ float silu_f(float x) { return x * __builtin_amdgcn_rcpf(1.f + __builtin_amdgcn_exp2f(x * -1.4426950408889634f)); }
__device__ __forceinline__ float shx(float v, int mask, int lane) { return __builtin_bit_cast(float, __builtin_amdgcn_ds_bpermute((lane ^ mask) << 2, __builtin_bit_cast(int, v))); }
__device__ __forceinline__ float shup(float v, int d, int lane) { return __builtin_bit_cast(float, __builtin_amdgcn_ds_bpermute((lane - d) << 2, __builtin_bit_cast(int, v))); }
__device__ __forceinline__ float wave_sum(float v, int lane) {
#pragma unroll
    for (int o = 32; o >= 1; o >>= 1) v += shx(v, o, lane);
    return v;
}
__device__ __forceinline__ float wave_max(float v, int lane) {
#pragma unroll
    for (int o = 32; o >= 1; o >>= 1) v = fmaxf(v, shx(v, o, lane));
    return v;
}
#define DPP_F(old, v, ctrl, rmask) __builtin_bit_cast(float, __builtin_amdgcn_update_dpp(__builtin_bit_cast(int, (float)(old)), __builtin_bit_cast(int, (float)(v)), ctrl, rmask, 0xf, false))
__device__ __forceinline__ float wave_incl_sum(float v, int lane) {
    (void)lane;
    v += DPP_F(0.f, v, 0x111, 0xf); v += DPP_F(0.f, v, 0x112, 0xf); v += DPP_F(0.f, v, 0x114, 0xf); v += DPP_F(0.f, v, 0x118, 0xf);
    v += DPP_F(0.f, v, 0x142, 0xa);
    v += DPP_F(0.f, v, 0x143, 0xc);
    return v;
}
__device__ __forceinline__ float wave_incl_max(float v, int lane) {
    (void)lane;
    const float ninf = -INFINITY;
    v = fmaxf(v, DPP_F(ninf, v, 0x111, 0xf)); v = fmaxf(v, DPP_F(ninf, v, 0x112, 0xf)); v = fmaxf(v, DPP_F(ninf, v, 0x114, 0xf)); v = fmaxf(v, DPP_F(ninf, v, 0x118, 0xf));
    v = fmaxf(v, DPP_F(ninf, v, 0x142, 0xa));
    v = fmaxf(v, DPP_F(ninf, v, 0x143, 0xc));
    return v;
}
__device__ __forceinline__ float sum4(f32x4 a) { return (a[0] + a[1]) + (a[2] + a[3]); }
__device__ __forceinline__ float rowscale(const float* ssq, int row) {
    const float* s = ssq + (size_t)row * 16;
    const f32x4 a = *(const f32x4*)s, b = *(const f32x4*)(s + 4), c = *(const f32x4*)(s + 8), d = *(const f32x4*)(s + 12);
    const float t = (sum4(a) + sum4(b)) + (sum4(c) + sum4(d));
    return rsqrtf(t * (1.0f / 1024.0f) + EPS);
}
__device__ __forceinline__ int swz(int row, int ch) { return row * 256 + ((ch ^ (row & 15)) << 4); }

__device__ __forceinline__ void rtable_build(const float* ssq, int row_base, int wr, int wc, int fr, int fq, PG8_LAS float* rl) {
    const int lane = fq * 16 + fr, t = wc * 64 + lane, idx = t >> 1, hsel = t & 1;
    const int lrow = (idx >> 6) * 128 + wr * 64 + (idx & 63);
    const float* s = ssq + (size_t)(row_base + lrow) * 16 + hsel * 8;
    const f32x4 a = *(const f32x4*)s, b = *(const f32x4*)(s + 4);
    float v = sum4(a) + sum4(b);
    v += shx(v, 1, lane);
    if (hsel == 0) rl[lrow] = rsqrtf(v * (1.0f / 1024.0f) + EPS);
    asm volatile("s_waitcnt lgkmcnt(0)" ::: "memory"); __builtin_amdgcn_s_barrier(); asm volatile("" ::: "memory");
}
struct EpiProj {
    static constexpr bool PERM = true, AFTER_DRAIN = false, APERM = false;
    bf16_t* proj; const float* ssq; float* lnstat; PG8_LAS float* rl;
    __device__ __forceinline__ void operator()(const f32x4 (&acc)[2][2][4][2], const pg8::Unit& u, int wr, int wc, int fr_in, int fq_in) const {
        (void)fr_in; (void)fq_in; const int lane = otid() & 63, fr = lane & 15, fq = lane >> 4;
        const int row0 = u.pm * 256 + wr * 64 + fr, col0 = u.pn * 256 + wc * 32 + 8 * fq;
        const int mode = (u.pn == 4 || u.pn == 5) ? 2 : 3;
        rtable_build(ssq, u.pm * 256, wr, wc, fr, fq, rl);
#pragma unroll
        for (int ai = 0; ai < 2; ++ai)
#pragma unroll
            for (int m = 0; m < 4; ++m) {
                const int row = row0 + ai * 128 + m * 16;
                const float r = rl[ai * 128 + wr * 64 + m * 16 + fr];
                float s1 = 0.f, s2 = 0.f;
                bf16_t* rp = proj + (size_t)row * PROJ_LD + col0;
#pragma unroll
                for (int bj = 0; bj < 2; ++bj) {
                    f32x4 v0 = acc[ai][bj][m][0] * r, v1 = acc[ai][bj][m][1] * r;
                    if (mode == 0 || mode == 2) {
                        const f32x2 a = gelu_pk((f32x2){v0[0], v0[1]}), b = gelu_pk((f32x2){v0[2], v0[3]}), c = gelu_pk((f32x2){v1[0], v1[1]}), d = gelu_pk((f32x2){v1[2], v1[3]});
                        v0 = (f32x4){a.x, a.y, b.x, b.y}; v1 = (f32x4){c.x, c.y, d.x, d.y};
                    } else if (mode == 1) {
#pragma unroll
                        for (int j = 0; j < 4; ++j) { v0[j] = sigmoid_f(v0[j]); v1[j] = sigmoid_f(v1[j]); }
                    }
                    if (mode == 2) {
                        s1 += sum4(v0) + sum4(v1);
                        s2 += sum4(v0 * v0) + sum4(v1 * v1);
                    }
                    u32x4 w; w.x = cvt_pk_bf16(v0[0], v0[1]); w.y = cvt_pk_bf16(v0[2], v0[3]); w.z = cvt_pk_bf16(v1[0], v1[1]); w.w = cvt_pk_bf16(v1[2], v1[3]);
                    *(u32x4*)(rp + bj * 128) = w;
                }
                if (mode == 2) {
                    s1 += shx(s1, 16, lane); s1 += shx(s1, 32, lane);
                    s2 += shx(s2, 16, lane); s2 += shx(s2, 32, lane);
                    if (fq == 0) { float* st = lnstat + (size_t)row * 16 + ((u.pn - 4) * 4 + wc) * 2; st[0] = s1; st[1] = s2; }
                }
            }
    }
};
struct EpiResid {
    static constexpr bool PERM = true, AFTER_DRAIN = false, APERM = false;
    const float* xin; float* xout; bf16_t* xb; float* ssq; int row_off; int dry;
    __device__ __forceinline__ void operator()(const f32x4 (&acc)[2][2][4][2], const pg8::Unit& u, int wr, int wc, int fr_in, int fq_in) const {
        (void)fr_in; (void)fq_in; const int lane = otid() & 63, fr = lane & 15, fq = lane >> 4;
        const int row0 = row_off + u.pm * 256 + wr * 64 + fr, col0 = u.pn * 256 + wc * 32 + 8 * fq;
        f32x4 xa[2][2][2], xc[2][2][2];
#define RESID_LD(q, buf) do { _Pragma("unroll") for (int mm = 0; mm < 2; ++mm) _Pragma("unroll") for (int bj = 0; bj < 2; ++bj) { \
            const float* xi = xin + (size_t)(row0 + ((q) >> 1) * 128 + (((q) & 1) * 2 + mm) * 16) * DM + col0 + bj * 128; buf[mm][bj][0] = *(const f32x4*)xi; buf[mm][bj][1] = *(const f32x4*)(xi + 4); } } while (0)
#define RESID_ST(q, buf) do { _Pragma("unroll") for (int mm = 0; mm < 2; ++mm) { const int ai = (q) >> 1, m = ((q) & 1) * 2 + mm, row = row0 + ai * 128 + m * 16; const size_t base = (size_t)row * DM + col0; float s = 0.f; \
            _Pragma("unroll") for (int bj = 0; bj < 2; ++bj) { const f32x4 v0 = acc[ai][bj][m][0] + buf[mm][bj][0], v1 = acc[ai][bj][m][1] + buf[mm][bj][1]; float* xo = xout + base + bj * 128; \
                if (!dry) { *(f32x4*)xo = v0; *(f32x4*)(xo + 4) = v1; } s += sum4(v0 * v0) + sum4(v1 * v1); \
                u32x4 w; w.x = cvt_pk_bf16(v0[0], v0[1]); w.y = cvt_pk_bf16(v0[2], v0[3]); w.z = cvt_pk_bf16(v1[0], v1[1]); w.w = cvt_pk_bf16(v1[2], v1[3]); if (!dry) *(u32x4*)(xb + base + bj * 128) = w; } \
            s += shx(s, 16, lane); s += shx(s, 32, lane); if (fq == 0 && (!dry || s == 12345.678f)) ssq[(size_t)row * 16 + u.pn * 4 + wc] = s; } } while (0)
        RESID_LD(0, xa); RESID_LD(1, xc);
        RESID_ST(0, xa); RESID_LD(2, xa);
        RESID_ST(1, xc); RESID_LD(3, xc);
        RESID_ST(2, xa);
        RESID_ST(3, xc);
#undef RESID_LD
#undef RESID_ST
    }
};
__device__ __forceinline__ float dpp_ror1(float v) { return __builtin_bit_cast(float, __builtin_amdgcn_mov_dpp(__builtin_bit_cast(int, v), 0x121, 0xf, 0xf, true)); }
__device__ __forceinline__ float dpp_shr1(float v) { return __builtin_bit_cast(float, __builtin_amdgcn_mov_dpp(__builtin_bit_cast(int, v), 0x111, 0xf, 0xf, true)); }
__device__ __forceinline__ float dpp_ror2(float v) { return __builtin_bit_cast(float, __builtin_amdgcn_mov_dpp(__builtin_bit_cast(int, v), 0x122, 0xf, 0xf, true)); }
struct EpiUpAct {
    static constexpr bool PERM = true, AFTER_DRAIN = false, APERM = true;
    bf16_t* act; float* halo; const float* ssq; const float* cw; const float* cb; PG8_LAS float* rl;
    __device__ __forceinline__ void operator()(const f32x4 (&acc)[2][2][4][2], const pg8::Unit& u, int wr, int wc, int fr_in, int fq_in) const {
        (void)fr_in; (void)fq_in; const int lane = otid() & 63, fr = lane & 15, fq = lane >> 4;
        const int rowb = u.pm * 256 + wr * 64, ch0 = u.pn * 128 + wc * 32 + 8 * fq;
        PG8_LAS f32x4* wt = (PG8_LAS f32x4*)(rl + 256) + wr * 256;
        {
            const int t = wc * 64 + fq * 16 + fr, c = t >> 1, part = t & 1;
            const float* wp = cw + u.pn * 128 + c + part * DFF;
            f32x4 v; v[0] = wp[0]; v[1] = wp[UPN]; v[2] = wp[2 * UPN]; v[3] = cb[u.pn * 128 + c + part * DFF];
            wt[t] = v;
        }
        rtable_build(ssq, u.pm * 256, wr, wc, fr, fq, rl);
#pragma unroll
        for (int ai = 0; ai < 2; ++ai) {
            const int blk = (rowb + ai * 128) >> 6;
            if (fr == 0 || fr == 15) {
                const int mb = fr == 0 ? 0 : 2;
                const float ra = rl[ai * 128 + wr * 64 + 4 * fr + mb], rb2 = rl[ai * 128 + wr * 64 + 4 * fr + mb + 1];
                float* hp = halo + (size_t)(blk * 4 + mb) * UPN + ch0;
#pragma unroll
                for (int n = 0; n < 2; ++n) {
                    const f32x4 a0 = fr == 0 ? acc[ai][0][0][n] : acc[ai][0][2][n], a1 = fr == 0 ? acc[ai][0][1][n] : acc[ai][0][3][n];
                    const f32x4 b0 = fr == 0 ? acc[ai][1][0][n] : acc[ai][1][2][n], b1 = fr == 0 ? acc[ai][1][1][n] : acc[ai][1][3][n];
                    *(f32x4*)(hp + 4 * n) = a0 * ra; *(f32x4*)(hp + DFF + 4 * n) = b0 * ra;
                    *(f32x4*)(hp + UPN + 4 * n) = a1 * rb2; *(f32x4*)(hp + UPN + DFF + 4 * n) = b1 * rb2;
                }
            }
        }
        __builtin_amdgcn_sched_barrier(0);
#pragma unroll
        for (int ai = 0; ai < 2; ++ai) {
            const int rb = rowb + ai * 128;
            const f32x4 r4 = *(const PG8_LAS f32x4*)(rl + ai * 128 + wr * 64 + 4 * fr);
            unsigned pk[4][4];
#pragma unroll
            for (int n = 0; n < 2; ++n) {
                float oprev[4];
#pragma unroll
                for (int j = 0; j < 4; ++j) {
                    const int cl = wc * 32 + 8 * fq + 4 * n + j;
                    const f32x4 wa = wt[cl * 2], wb = wt[cl * 2 + 1];
                    float s[4];
                    {
                        float x[4];
#pragma unroll
                        for (int m = 0; m < 4; ++m) x[m] = acc[ai][0][m][n][j] * r4[m];
                        const float q3 = dpp_shr1(x[3]), q2 = dpp_shr1(x[2]);
                        s[0] = silu_f(wa[3] + wa[0] * q2 + wa[1] * q3 + wa[2] * x[0]);
                        s[1] = silu_f(wa[3] + wa[0] * q3 + wa[1] * x[0] + wa[2] * x[1]);
                        s[2] = silu_f(wa[3] + wa[0] * x[0] + wa[1] * x[1] + wa[2] * x[2]);
                        s[3] = silu_f(wa[3] + wa[0] * x[1] + wa[1] * x[2] + wa[2] * x[3]);
                    }
                    {
                        float x[4];
#pragma unroll
                        for (int m = 0; m < 4; ++m) x[m] = acc[ai][1][m][n][j] * r4[m];
                        const float q3 = dpp_shr1(x[3]), q2 = dpp_shr1(x[2]);
                        s[0] *= wb[3] + wb[0] * q2 + wb[1] * q3 + wb[2] * x[0];
                        s[1] *= wb[3] + wb[0] * q3 + wb[1] * x[0] + wb[2] * x[1];
                        s[2] *= wb[3] + wb[0] * x[0] + wb[1] * x[1] + wb[2] * x[2];
                        s[3] *= wb[3] + wb[0] * x[1] + wb[1] * x[2] + wb[2] * x[3];
                    }
#pragma unroll
                    for (int m = 0; m < 4; ++m) { if (j & 1) pk[m][2 * n + (j >> 1)] = cvt_pk_bf16(oprev[m], s[m]); else oprev[m] = s[m]; }
                    __builtin_amdgcn_sched_barrier(0);
                }
            }
#pragma unroll
            for (int m = 0; m < 4; ++m) {
                if (m > 1 || fr > 0) { u32x4 w; w.x = pk[m][0]; w.y = pk[m][1]; w.z = pk[m][2]; w.w = pk[m][3]; *(u32x4*)(act + (size_t)(rb + 4 * fr + m) * DFF + ch0) = w; }
            }
        }
    }
};
struct EpiPe {
    static constexpr bool PERM = true, AFTER_DRAIN = false, APERM = false;
    bf16_t* pe;
    __device__ __forceinline__ void operator()(const f32x4 (&acc)[2][2][4][2], const pg8::Unit& u, int wr, int wc, int fr_in, int fq_in) const {
        (void)fr_in; (void)fq_in; const int lane = otid() & 63, fr = lane & 15, fq = lane >> 4;
        const int row0 = u.pm * 256 + wr * 64 + fr, col0 = u.pn * 256 + wc * 32 + 8 * fq;
#pragma unroll
        for (int ai = 0; ai < 2; ++ai)
#pragma unroll
            for (int m = 0; m < 4; ++m) {
                const int row = row0 + ai * 128 + m * 16;
                bf16_t* rp = pe + (size_t)row * DM + col0;
#pragma unroll
                for (int bj = 0; bj < 2; ++bj) {
                    const f32x4 v0 = acc[ai][bj][m][0], v1 = acc[ai][bj][m][1];
                    u32x4 w; w.x = cvt_pk_bf16(v0[0], v0[1]); w.y = cvt_pk_bf16(v0[2], v0[3]); w.z = cvt_pk_bf16(v1[0], v1[1]); w.w = cvt_pk_bf16(v1[2], v1[3]);
                    *(u32x4*)(rp + bj * 128) = w;
                }
            }
    }
};
struct EpiGate {
    static constexpr bool PERM = true, AFTER_DRAIN = false, APERM = false;
    float* x; const bf16_t* pe; const float* ssq_in; bf16_t* xb; float* ssq; PG8_LAS float* rl; int dry;
    __device__ __forceinline__ void operator()(const f32x4 (&acc)[2][2][4][2], const pg8::Unit& u, int wr, int wc, int fr_in, int fq_in) const {
        (void)fr_in; (void)fq_in; const int lane = otid() & 63, fr = lane & 15, fq = lane >> 4;
        const int row0 = u.pm * 256 + wr * 64 + fr, col0 = u.pn * 256 + wc * 32 + 8 * fq;
        rtable_build(ssq_in, u.pm * 256, wr, wc, fr, fq, rl);
        f32x4 xa[2][2][2]; u32x4 pa[2][2];
#define GATE_LD(q, buf, pbuf) do { _Pragma("unroll") for (int mm = 0; mm < 2; ++mm) _Pragma("unroll") for (int bj = 0; bj < 2; ++bj) { \
            const size_t off = (size_t)(row0 + ((q) >> 1) * 128 + (((q) & 1) * 2 + mm) * 16) * DM + col0 + bj * 128; buf[mm][bj][0] = *(const f32x4*)(x + off); buf[mm][bj][1] = *(const f32x4*)(x + off + 4); pbuf[mm][bj] = *(const u32x4*)(pe + off); } } while (0)
#define GATE_ST(q, buf, pbuf) do { _Pragma("unroll") for (int mm = 0; mm < 2; ++mm) { const int ai = (q) >> 1, m = ((q) & 1) * 2 + mm, row = row0 + ai * 128 + m * 16; const size_t base = (size_t)row * DM + col0; float s = 0.f; \
            const float r = rl[ai * 128 + wr * 64 + m * 16 + fr]; \
            _Pragma("unroll") for (int bj = 0; bj < 2; ++bj) { f32x4 g0 = acc[ai][bj][m][0] * r, g1 = acc[ai][bj][m][1] * r; \
                _Pragma("unroll") for (int j = 0; j < 4; ++j) { g0[j] = sigmoid_f(g0[j]); g1[j] = sigmoid_f(g1[j]); } \
                const u32x4 pv = pbuf[mm][bj]; const f32x4 p0 = (f32x4){bflo(pv.x), bfhi(pv.x), bflo(pv.y), bfhi(pv.y)}, p1 = (f32x4){bflo(pv.z), bfhi(pv.z), bflo(pv.w), bfhi(pv.w)}; \
                const f32x4 v0 = buf[mm][bj][0] + g0 * p0, v1 = buf[mm][bj][1] + g1 * p1; float* xo = x + base + bj * 128; \
                if (!dry) { *(f32x4*)xo = v0; *(f32x4*)(xo + 4) = v1; } s += sum4(v0 * v0) + sum4(v1 * v1); \
                u32x4 w; w.x = cvt_pk_bf16(v0[0], v0[1]); w.y = cvt_pk_bf16(v0[2], v0[3]); w.z = cvt_pk_bf16(v1[0], v1[1]); w.w = cvt_pk_bf16(v1[2], v1[3]); if (!dry) *(u32x4*)(xb + base + bj * 128) = w; } \
            s += shx(s, 16, lane); s += shx(s, 32, lane); if (fq == 0 && (!dry || s == 12345.678f)) ssq[(size_t)row * 16 + u.pn * 4 + wc] = s; } } while (0)
        GATE_LD(0, xa, pa); GATE_ST(0, xa, pa);
        GATE_LD(1, xa, pa); GATE_ST(1, xa, pa);
        GATE_LD(2, xa, pa); GATE_ST(2, xa, pa);
        GATE_LD(3, xa, pa); GATE_ST(3, xa, pa);
#undef GATE_LD
#undef GATE_ST
    }
};

template <class Epi>
__device__ __forceinline__ void run_gemm(ldsp lds, const bf16_t* A, int lda, const bf16_t* Bt, int M, int N, int K, const Epi& E) {
    pg8::Gemm g; g.A = A; g.Bt = Bt; g.M = M; g.N = N; g.K = K; g.lda = lda;
    pg8::StaticOrder S; S.init(M, N, (int)gridDim.x, obid());
    pg8::gemm_phase<Epi, pg8::StaticOrder>(lds, g, S, E);
}

__device__ __forceinline__ void tr_tile(ldsp lds, const float* __restrict__ src, int ld, int c0, int k0, const float* __restrict__ g, bf16_t* __restrict__ dst, int Kd, int n0) {
    PG8_LAS float* tile = (PG8_LAS float*)lds;
    const int tid = otid();
#pragma unroll
    for (int i = 0; i < 2; ++i) {
        const int q = tid + i * 512, kr = q >> 4, c4 = (q & 15) * 4;
        const f32x4 v = *(const f32x4*)(src + (size_t)(k0 + kr) * ld + c0 + c4);
        const float s = g ? g[k0 + kr] : 1.f;
        tile[kr * 65 + c4 + 0] = v[0] * s; tile[kr * 65 + c4 + 1] = v[1] * s; tile[kr * 65 + c4 + 2] = v[2] * s; tile[kr * 65 + c4 + 3] = v[3] * s;
    }
    __syncthreads();
    {
        const int n = tid >> 3, kc = (tid & 7) * 8;
        float f[8];
#pragma unroll
        for (int j = 0; j < 8; ++j) f[j] = tile[(kc + j) * 65 + n];
        u32x4 w; w.x = cvt_pk_bf16(f[0], f[1]); w.y = cvt_pk_bf16(f[2], f[3]); w.z = cvt_pk_bf16(f[4], f[5]); w.w = cvt_pk_bf16(f[6], f[7]);
        *(u32x4*)(dst + (size_t)(n0 + n) * Kd + k0 + kc) = w;
    }
    __syncthreads();
}

__device__ __forceinline__ void prep_phase(ldsp lds, KP p) {
    const int tid = otid(), lane = tid & 63, w = __builtin_amdgcn_readfirstlane(tid >> 6);
    unsigned char* ws = p->ws;
    for (int j = obid(); j < 4 * 3456; j += gridDim.x) {
        const int l = j / 3456; int r = j % 3456;
        unsigned char* wt = ws + WS_WT + (size_t)l * WT_LAYER;
        const float* src; const float* g = nullptr; bf16_t* dst; int ld, c0, k0, Kd, n0;
        if (r < 768) { const int kt = r & 15, nt = r >> 4; n0 = nt * 64; k0 = kt * 64; src = p->in[3] + (size_t)l * 1024 * 3080; ld = 3080; c0 = n0 < 512 ? n0 : (n0 < 1024 ? n0 + 2048 : n0 - 512); g = p->in[2] + l * 1024; dst = (bf16_t*)(wt + WT_IN); Kd = 1024; }
        else if (r < 1024) { r -= 768; const int kt = r & 15, nt = r >> 4; n0 = nt * 64; k0 = kt * 64; src = p->in[13] + (size_t)l * 1024 * 1024; ld = 1024; c0 = n0; dst = (bf16_t*)(wt + WT_OUT); Kd = 1024; }
        else if (r < 2432) { r -= 1024; const int kt = r & 15, nt = r >> 4; n0 = nt * 64; k0 = kt * 64; src = p->in[15] + (size_t)l * 1024 * 5632; ld = 5632; c0 = ((n0 & 255) >> 7) * DFF + (n0 >> 8) * 128 + (n0 & 127); g = p->in[14] + l * 1024; dst = (bf16_t*)(wt + WT_UP); Kd = 1024; }
        else if (r < 3136) { r -= 2432; const int kt = r % 44, nt = r / 44; n0 = nt * 64; k0 = kt * 64; src = p->in[18] + (size_t)l * 2816 * 1024; ld = 1024; c0 = n0; dst = (bf16_t*)(wt + WT_DOWN); Kd = 2816; }
        else if (r < 3392) { r -= 3136; const int kt = r & 15, nt = r >> 4; n0 = nt * 64; k0 = kt * 64; src = p->in[20] + (size_t)l * 1024 * 1024; ld = 1024; c0 = n0; g = p->in[19] + l * 1024; dst = (bf16_t*)(wt + WT_GATE); Kd = 1024; }
        else { r -= 3392; const int kt = r & 3, nt = r >> 2; n0 = nt * 64; k0 = kt * 64; src = p->in[21] + (size_t)l * 256 * 1024; ld = 1024; c0 = n0; dst = (bf16_t*)(wt + WT_PLE); Kd = 256; }
        tr_tile(lds, src, ld, c0, k0, g, dst, Kd, n0);
    }
    const int gtid = obid() * 512 + tid, gthreads = gridDim.x * 512;
    for (int i = gtid; i < 4 * 8 * 128 * 16; i += gthreads) {
        const int l = i >> 14, rem = i & 16383, h = rem >> 11, t = (rem >> 4) & 127, s0 = (rem & 15) * 8;
        const float* src = p->in[6] + (size_t)i * 8;
        const f32x4 a = *(const f32x4*)src, b = *(const f32x4*)(src + 4);
        float f[8] = {a[0], a[1], a[2], a[3], b[0], b[1], b[2], b[3]};
#pragma unroll
        for (int j = 0; j < 8; ++j) f[j] = (s0 + j <= t) ? f[j] : 0.f;
        u32x4 wv; wv.x = cvt_pk_bf16(f[0], f[1]); wv.y = cvt_pk_bf16(f[2], f[3]); wv.z = cvt_pk_bf16(f[4], f[5]); wv.w = cvt_pk_bf16(f[6], f[7]);
        bf16_t* dst = (bf16_t*)(ws + WS_WT + (size_t)l * WT_LAYER + WT_WSB) + (size_t)(h * 128 + t) * 128 + s0;
        *(u32x4*)dst = wv;
    }
    for (int i = gtid; i < 4 * 1024 * 8; i += gthreads) {
        const int l = i >> 13, k = (i >> 3) & 1023, j = i & 7;
        ((float*)(ws + WS_WG))[i] = p->in[3][((size_t)l * 1024 + k) * 3080 + 3072 + j] * p->in[2][l * 1024 + k];
    }
    bf16_t* xb0 = (bf16_t*)(ws + WS_XB0); float* ssq0 = (float*)(ws + WS_SSQ0);
    for (int rowb = obid() * 8 + w; rowb < NTOK; rowb += gridDim.x * 8 * 4) {
        const int rstep = gridDim.x * 8;
        f32x4 xv[4][4];
#pragma unroll
        for (int u = 0; u < 4; ++u) { const int row = rowb + u * rstep < NTOK ? rowb + u * rstep : rowb;
#pragma unroll
            for (int i = 0; i < 4; ++i) xv[u][i] = *(const f32x4*)(p->in[0] + (size_t)row * DM + i * 256 + lane * 4); }
#pragma unroll
        for (int u = 0; u < 4; ++u) {
            const int row = rowb + u * rstep; float s = 0.f;
            if (row < NTOK) {
#pragma unroll
                for (int i = 0; i < 4; ++i) {
                    const f32x4 v = xv[u][i]; s += sum4(v * v);
                    u32x2 pk; pk.x = cvt_pk_bf16(v[0], v[1]); pk.y = cvt_pk_bf16(v[2], v[3]);
                    *(u32x2*)(xb0 + (size_t)row * DM + i * 256 + lane * 4) = pk;
                }
                s = wave_sum(s, lane);
                if (lane < 16) ssq0[(size_t)row * 16 + lane] = lane == 0 ? s : 0.f;
            }
        }
    }
}

__device__ __forceinline__ void gates_phase(ldsp lds, KP p, int l, const bf16_t* xb, const float* ssq, int part) {
    const int tid = otid(), lane = tid & 63, w = __builtin_amdgcn_readfirstlane(tid >> 6), fr = lane & 15, fq = lane >> 4;
    ldsp wt = lds;
    const float* wg = (const float*)(p->ws + WS_WG) + l * 8192;
    {
        const int k0 = tid * 2;
        const f32x4 a0 = *(const f32x4*)(wg + k0 * 8), a1 = *(const f32x4*)(wg + k0 * 8 + 4), b0 = *(const f32x4*)(wg + k0 * 8 + 8), b1 = *(const f32x4*)(wg + k0 * 8 + 12);
        const float v0[8] = {a0[0], a0[1], a0[2], a0[3], a1[0], a1[1], a1[2], a1[3]}, v1[8] = {b0[0], b0[1], b0[2], b0[3], b1[0], b1[1], b1[2], b1[3]};
#pragma unroll
        for (int n = 0; n < 8; ++n) {
            *(PG8_LAS unsigned*)(wt + n * 2048 + ((((k0 >> 3) ^ n) & 127) << 4) + (k0 & 7) * 2) = cvt_pk_bf16(v0[n], v1[n]);
            *(PG8_LAS unsigned*)(wt + (n + 8) * 2048 + ((((k0 >> 3) ^ (n + 8)) & 127) << 4) + (k0 & 7) * 2) = 0u;
        }
    }
    __syncthreads();
    float* gates = (float*)(p->ws + WS_GATES);
    int G8 = (int)gridDim.x * 8; asm volatile("" : "+s"(G8));
    const int nblk = NTOK / 16, per = (nblk + G8 - 1) / G8;
    const int b_lo = part == 1 ? per / 2 : 0, b_hi = part == 0 ? per / 2 : per;
    for (int bi = b_lo; bi < b_hi; ++bi) {
        const int blk = (obid() * 8 + w) * per + bi;
        if (blk >= nblk) break;
        const int row = blk * 16 + fr;
        const bf16_t* xr = xb + (size_t)row * DM + fq * 8;
        const float r = rowscale(ssq, row);
        f32x4 acc = (f32x4){0.f, 0.f, 0.f, 0.f};
#pragma unroll
        for (int kb = 0; kb < 4; ++kb) {
            bf16x8 a[8];
#pragma unroll
            for (int i = 0; i < 8; ++i) a[i] = *(const bf16x8*)(xr + (kb * 8 + i) * 32);
#pragma unroll
            for (int i = 0; i < 8; ++i) {
                const int ch = (kb * 8 + i) * 4 + fq;
                const bf16x8 b = *(const PG8_LAS bf16x8*)(wt + fr * 2048 + (((ch ^ fr) & 127) << 4));
                acc = __builtin_amdgcn_mfma_f32_16x16x32_bf16(b, a[i], acc, 0, 0, 0);
            }
        }
        if (fq < 2) {
            f32x4 o;
#pragma unroll
            for (int j = 0; j < 4; ++j) {
                const float z = r * acc[j] + (fq == 0 ? p->in[10][l * 4 + j] : p->in[11][l * 4 + j]);
                o[j] = fq == 0 ? z : fminf(z, 0.f) - __logf(1.0f + __expf(-fabsf(z)));
            }
            *(f32x4*)(gates + (size_t)row * 8 + fq * 4) = o;
        }
    }
    __syncthreads();
}

template <int NT>
__device__ __forceinline__ void strip_mma(ldsp A, int arow0, ldsp Bt, f32x4 (&acc)[NT], int lane, int kk_lo, int kk_hi, int nt_hi) {
    const int fr = lane & 15, fq = lane >> 4;
    for (int kk = kk_lo; kk < kk_hi; ++kk) {
        const int ch = kk * 4 + fq;
        const bf16x8 a = *(const PG8_LAS bf16x8*)(A + swz(arow0 + fr, ch));
#pragma unroll
        for (int nt = 0; nt < NT; ++nt) if (nt < nt_hi) {
            const bf16x8 b = *(const PG8_LAS bf16x8*)(Bt + swz(nt * 16 + fr, ch));
            acc[nt] = __builtin_amdgcn_mfma_f32_16x16x32_bf16(b, a, acc[nt], 0, 0, 0);
        }
    }
}

__device__ __forceinline__ void gmlp_task(ldsp lds, KP p, int l, int task, bool dry = false) {
    const int c = task >> 3, h = task & 7, tok0 = c * 128;
    const int tid = otid(), lane = tid & 63, w = __builtin_amdgcn_readfirstlane(tid >> 6);
    ldsp W = lds, VT = lds + 32768;
    bf16_t* proj = (bf16_t*)(p->ws + WS_PROJ);
    const bf16_t* wsb = (const bf16_t*)(p->ws + WS_WT + (size_t)l * WT_LAYER + WT_WSB) + (size_t)h * 16384;
    u32x4 wreg[4];
#pragma unroll
    for (int i = 0; i < 4; ++i) { const int q = tid + i * 512, row = q >> 4, ch = q & 15; wreg[i] = *(const u32x4*)(wsb + row * 128 + ch * 8); }
    {
        const int s = tid >> 2, cb = (tid & 3) * 16, tok = tok0 + s;
        const float* st = (const float*)(p->ws + WS_LNSTAT) + (size_t)tok * 16;
        const f32x4 a = *(const f32x4*)st, b = *(const f32x4*)(st + 4), c2 = *(const f32x4*)(st + 8), d = *(const f32x4*)(st + 12);
        const float s1 = (a[0] + a[2]) + (b[0] + b[2]) + (c2[0] + c2[2]) + (d[0] + d[2]);
        const float s2 = (a[1] + a[3]) + (b[1] + b[3]) + (c2[1] + c2[3]) + (d[1] + d[3]);
        const float mu = s1 * (1.0f / 512.0f), var = fmaxf(s2 * (1.0f / 512.0f) - mu * mu, 0.f), rstd = rsqrtf(var + EPS);
        const bf16_t* src = proj + (size_t)tok * PROJ_LD + 1024 + h * 64 + cb;
        const u32x4 r0 = *(const u32x4*)src, r1 = *(const u32x4*)(src + 8);
        const unsigned rw[8] = {r0.x, r0.y, r0.z, r0.w, r1.x, r1.y, r1.z, r1.w};
        const float* lgp = p->in[4] + l * 512 + h * 64 + cb; const float* lbp = p->in[5] + l * 512 + h * 64 + cb;
        const f32x4 g0 = *(const f32x4*)lgp, g1 = *(const f32x4*)(lgp + 4), g2 = *(const f32x4*)(lgp + 8), g3 = *(const f32x4*)(lgp + 12);
        const f32x4 b0 = *(const f32x4*)lbp, b1 = *(const f32x4*)(lbp + 4), b2 = *(const f32x4*)(lbp + 8), b3 = *(const f32x4*)(lbp + 12);
        const float lg[16] = {g0[0], g0[1], g0[2], g0[3], g1[0], g1[1], g1[2], g1[3], g2[0], g2[1], g2[2], g2[3], g3[0], g3[1], g3[2], g3[3]};
        const float lb[16] = {b0[0], b0[1], b0[2], b0[3], b1[0], b1[1], b1[2], b1[3], b2[0], b2[1], b2[2], b2[3], b3[0], b3[1], b3[2], b3[3]};
#pragma unroll
        for (int j = 0; j < 16; ++j) {
            const float x = (j & 1) ? bfhi(rw[j >> 1]) : bflo(rw[j >> 1]);
            const float y = (x - mu) * rstd * lg[j] + lb[j];
            const int dd = cb + j;
            *(PG8_LAS bf16_t*)(VT + dd * 256 + (((s >> 3) ^ (dd & 15)) << 4) + (s & 7) * 2) = f2bf(y);
        }
    }
#pragma unroll
    for (int i = 0; i < 4; ++i) { const int q = tid + i * 512, row = q >> 4, ch = q & 15; *(PG8_LAS u32x4*)(W + swz(row, ch)) = wreg[i]; }
    u32x2 uup[4]; float bs;
    {
        const int t = 16 * w + (lane & 15), tok = tok0 + t, fq = lane >> 4;
        bs = p->in[7][(l * 8 + h) * 128 + t];
#pragma unroll
        for (int nt = 0; nt < 4; ++nt) uup[nt] = *(const u32x2*)(proj + (size_t)tok * PROJ_LD + h * 64 + nt * 16 + fq * 4);
    }
    __syncthreads();
    f32x4 acc[4];
#pragma unroll
    for (int i = 0; i < 4; ++i) acc[i] = (f32x4){0.f, 0.f, 0.f, 0.f};
    const int kk_hi = (16 * w + 15) / 32 + 1;
    strip_mma<4>(W, 16 * w, VT, acc, lane, 0, kk_hi, 4);
    {
        const int t = 16 * w + (lane & 15), tok = tok0 + t, fq = lane >> 4;
#pragma unroll
        for (int nt = 0; nt < 4; ++nt) {
            bf16_t* up = proj + (size_t)tok * PROJ_LD + h * 64 + nt * 16 + fq * 4;
            const u32x2 uu = uup[nt];
            const f32x2 g0 = gelu_pk((f32x2){bflo(uu.x), bfhi(uu.x)}), g1 = gelu_pk((f32x2){bflo(uu.y), bfhi(uu.y)});
            u32x2 o; o.x = cvt_pk_bf16(g0.x * (acc[nt][0] + bs), g0.y * (acc[nt][1] + bs)); o.y = cvt_pk_bf16(g1.x * (acc[nt][2] + bs), g1.y * (acc[nt][3] + bs));
            if (!dry) *(u32x2*)up = o;
        }
    }
    __syncthreads();
}

__device__ __forceinline__ void conv_table_fill(PG8_LAS float* wts, const float* cw, const float* cb, int h, int tid) {
    if (tid < 320) {
        const int part = tid >> 6, c4 = (tid & 63) * 4, gch = c4 < 128 ? h * 128 + c4 : 512 + h * 128 + (c4 - 128);
        const f32x4 v = part < 4 ? *(const f32x4*)(cw + part * 1024 + gch) : *(const f32x4*)(cb + gch);
        *(PG8_LAS f32x4*)(wts + part * 256 + c4) = v;
    }
}
__device__ __forceinline__ void conv_rows_load(const bf16_t* proj, int tok, int spos, int col, u32x4 (&r)[4][2]) {
#pragma unroll
    for (int jj = 0; jj < 4; ++jj) {
        const bf16_t* src = proj + (size_t)(spos - 3 + jj >= 0 ? tok - 3 + jj : tok) * PROJ_LD + col;
        r[jj][0] = *(const u32x4*)src; r[jj][1] = *(const u32x4*)(src + 8);
    }
}
__device__ __forceinline__ void conv16_regs(const u32x4 (&r)[4][2], int spos, const PG8_LAS float* wts, int lc0, float (&o)[16]) {
#pragma unroll
    for (int q = 0; q < 4; ++q) { const f32x4 b = *(const PG8_LAS f32x4*)(wts + 4 * 256 + lc0 + q * 4); o[q * 4 + 0] = b[0]; o[q * 4 + 1] = b[1]; o[q * 4 + 2] = b[2]; o[q * 4 + 3] = b[3]; }
#pragma unroll
    for (int jj = 0; jj < 4; ++jj) {
        const float vm = spos - 3 + jj >= 0 ? 1.f : 0.f;
        const unsigned rw[8] = {r[jj][0].x, r[jj][0].y, r[jj][0].z, r[jj][0].w, r[jj][1].x, r[jj][1].y, r[jj][1].z, r[jj][1].w};
#pragma unroll
        for (int q = 0; q < 4; ++q) {
            const f32x4 wv = *(const PG8_LAS f32x4*)(wts + jj * 256 + lc0 + q * 4) * vm;
            o[q * 4 + 0] += wv[0] * bflo(rw[q * 2]); o[q * 4 + 1] += wv[1] * bfhi(rw[q * 2]);
            o[q * 4 + 2] += wv[2] * bflo(rw[q * 2 + 1]); o[q * 4 + 3] += wv[3] * bfhi(rw[q * 2 + 1]);
        }
    }
#pragma unroll
    for (int j = 0; j < 16; ++j) o[j] = silu_f(o[j]);
}

struct DcPre { u32x4 rk[2][4][2]; u32x4 rv[2][2]; float ig0, lf0, ig1, lf1; };
__device__ __forceinline__ void dc_prefetch(KP p, int cidx, int tid, DcPre& R) {
    const int n = cidx & 127, bh = cidx >> 7, h = bh & 3, b = bh >> 2, tok0 = b * SEQ + n * 128;
    const int lane = tid & 63, w = __builtin_amdgcn_readfirstlane(tid >> 6);
    const bf16_t* proj = (const bf16_t*)(p->ws + WS_PROJ);
    const int lr = tid >> 2, cb = (tid & 3) * 32, tok = tok0 + lr, spos = n * 128 + lr;
#pragma unroll
    for (int hf = 0; hf < 2; ++hf) {
        const int c0 = cb + hf * 16;
        conv_rows_load(proj, tok, spos, 2048 + h * 128 + c0, R.rk[hf]);
        const bf16_t* vs = proj + (size_t)tok * PROJ_LD + 2560 + h * 128 + c0;
        R.rv[hf][0] = *(const u32x4*)vs; R.rv[hf][1] = *(const u32x4*)(vs + 8);
    }
    if (w == 0) {
        const float* gates = (const float*)(p->ws + WS_GATES);
        const int l0 = 2 * lane;
        R.ig0 = gates[(size_t)(tok0 + l0) * 8 + h]; R.lf0 = gates[(size_t)(tok0 + l0) * 8 + 4 + h];
        R.ig1 = gates[(size_t)(tok0 + l0 + 1) * 8 + h]; R.lf1 = gates[(size_t)(tok0 + l0 + 1) * 8 + 4 + h];
    }
}
__device__ __forceinline__ void mlstm_dc_task(ldsp lds, KP p, int l, int cidx, DcPre& R, int next_cidx) {
    const int n = cidx & 127, bh = cidx >> 7, h = bh & 3;
    const int tid = otid(), lane = tid & 63, w = __builtin_amdgcn_readfirstlane(tid >> 6);
    ldsp KT = lds, VT = lds + 32768; PG8_LAS float* wl = (PG8_LAS float*)(lds + 131072);
    PG8_LAS float* wts = (PG8_LAS float*)(lds + 131072 + 2560);
    conv_table_fill(wts, p->in[8] + (size_t)l * 4096, p->in[9] + l * 1024, h, tid);
    const int lr = tid >> 2, cb = (tid & 3) * 32, spos = n * 128 + lr;
    if (w == 0) {
        const int l0 = 2 * lane;
        const float ig0 = R.ig0, lf0 = R.lf0, ig1 = R.ig1, lf1 = R.lf1;
        const float incl = wave_incl_sum(lf0 + lf1, lane);
        const float b1 = incl, b0 = incl - lf1, bL = __builtin_bit_cast(float, __builtin_amdgcn_readlane(__builtin_bit_cast(int, incl), 63));
        const float a0 = bL - b0 + ig0, a1 = bL - b1 + ig1;
        const float amax = wave_max(fmaxf(a0, a1), lane);
        wl[l0] = __expf(a0 - amax); wl[l0 + 1] = __expf(a1 - amax);
        if (lane == 0) { ((float*)(p->ws + WS_CHBL))[cidx] = bL; ((float*)(p->ws + WS_CHAMAX))[cidx] = amax; }
    }
    __syncthreads();
    {
        const float wgt = wl[lr] * 0.08838834764831845f;
#pragma unroll
        for (int hf = 0; hf < 2; ++hf) {
            const int c0 = cb + hf * 16;
            float o[16];
            conv16_regs(R.rk[hf], spos, wts, 128 + c0, o);
#pragma unroll
            for (int j = 0; j < 16; ++j) { const int d = c0 + j; *(PG8_LAS bf16_t*)(KT + d * 256 + (((lr >> 3) ^ (d & 15)) << 4) + (lr & 7) * 2) = f2bf(o[j] * wgt); }
            const unsigned rw[8] = {R.rv[hf][0].x, R.rv[hf][0].y, R.rv[hf][0].z, R.rv[hf][0].w, R.rv[hf][1].x, R.rv[hf][1].y, R.rv[hf][1].z, R.rv[hf][1].w};
#pragma unroll
            for (int j = 0; j < 16; ++j) { const int e = c0 + j; const unsigned v16 = (j & 1) ? (rw[j >> 1] >> 16) : (rw[j >> 1] & 0xffffu);
                *(PG8_LAS bf16_t*)(VT + e * 256 + (((lr >> 3) ^ (e & 15)) << 4) + (lr & 7) * 2) = (bf16_t)v16; }
        }
    }
    __syncthreads();
    if (next_cidx >= 0) dc_prefetch(p, next_cidx, tid, R);
    if (tid < 128) {
        const int d = tid; float s = 0.f;
#pragma unroll
        for (int pc = 0; pc < 16; ++pc) {
            const u32x4 v = *(const PG8_LAS u32x4*)(KT + d * 256 + ((pc ^ (d & 15)) << 4));
            s += (bflo(v.x) + bfhi(v.x)) + (bflo(v.y) + bfhi(v.y)) + (bflo(v.z) + bfhi(v.z)) + (bflo(v.w) + bfhi(v.w));
        }
        ((float*)(p->ws + WS_DN))[(size_t)cidx * 128 + d] = s;
    }
    f32x4 acc[8];
#pragma unroll
    for (int i = 0; i < 8; ++i) acc[i] = (f32x4){0.f, 0.f, 0.f, 0.f};
    strip_mma<8>(VT, 16 * w, KT, acc, lane, 0, 4, 8);
    {
        const int e = 16 * w + (lane & 15), fq = lane >> 4;
        bf16_t* dst = (bf16_t*)(p->ws + WS_DC) + ((size_t)cidx * 128 + e) * 128 + fq * 4;
#pragma unroll
        for (int nt = 0; nt < 8; ++nt) { u32x2 o; o.x = cvt_pk_bf16(acc[nt][0], acc[nt][1]); o.y = cvt_pk_bf16(acc[nt][2], acc[nt][3]); *(u32x2*)(dst + nt * 16) = o; }
    }
    __syncthreads();
}
__device__ __forceinline__ void mlstm_dc_all(ldsp lds, KP p, int l) {
    const int G = (int)gridDim.x; int t = obid();
    if (t >= 1024) return;
    DcPre R;
    R.ig0 = R.lf0 = R.ig1 = R.lf1 = 0.f;
    dc_prefetch(p, t, otid(), R);
    for (; t < 1024; t += G) mlstm_dc_task(lds, p, l, t, R, t + G < 1024 ? t + G : -1);
}

__device__ __forceinline__ void scan_phase(KP p, bool dry = false) {
    const int gtid = obid() * 512 + otid(), gthreads = gridDim.x * 512;
    const float* __restrict__ chbl = (const float*)(p->ws + WS_CHBL); const float* __restrict__ cham = (const float*)(p->ws + WS_CHAMAX);
    float* m0 = (float*)(p->ws + WS_CHM0);
    for (int idx = gtid; idx < 8 * 16384; idx += gthreads) {
        const int bh = idx >> 14, el = idx & 16383;
        bf16_t* ptr = (bf16_t*)(p->ws + WS_DC) + (size_t)bh * 128 * 16384 + el;
        const bool hasn = idx < 1024;
        const int bh2 = (idx >> 7) & 7, d2 = idx & 127;
        float* nptr = (float*)(p->ws + WS_DN) + (size_t)bh2 * 128 * 128 + d2;
        float C = 0.f, m = 0.f, nv = 0.f, m2 = 0.f;
        for (int c0 = 0; c0 < 128; c0 += 16) {
            float d[16], bl[16], am[16], dn[16], bl2[16], am2[16];
#pragma unroll
            for (int u = 0; u < 16; ++u) { d[u] = bf2f(ptr[(size_t)(c0 + u) * 16384]); bl[u] = chbl[bh * 128 + c0 + u]; am[u] = cham[bh * 128 + c0 + u]; }
            if (hasn) {
#pragma unroll
                for (int u = 0; u < 16; ++u) { dn[u] = nptr[(c0 + u) * 128]; bl2[u] = chbl[bh2 * 128 + c0 + u]; am2[u] = cham[bh2 * 128 + c0 + u]; }
            }
#pragma unroll
            for (int u = 0; u < 16; ++u) {
                const float mn = fmaxf(bl[u] + m, am[u]), dec = __expf(bl[u] + m - mn), sc = __expf(am[u] - mn);
                if (!dry) ptr[(size_t)(c0 + u) * 16384] = f2bf(C);
                C = dec * C + sc * d[u]; m = mn;
            }
            if (hasn) {
#pragma unroll
                for (int u = 0; u < 16; ++u) {
                    const float mn = fmaxf(bl2[u] + m2, am2[u]), dec = __expf(bl2[u] + m2 - mn), sc = __expf(am2[u] - mn);
                    if (!dry) { nptr[(c0 + u) * 128] = nv;
                    if (d2 == 0) m0[bh2 * 128 + c0 + u] = m2; }
                    nv = dec * nv + sc * dn[u]; m2 = mn;
                }
            }
        }
        if (dry && C == 12345.678f && nv == 3.25f) m0[0] = C + nv + m + m2;
    }
}

struct OutPre { u32x4 rc[4]; u32x4 rq[4][2]; u32x4 rk[4][2]; u32x4 rv[2]; float m0, ig0, lf0, ig1, lf1, n0v; };
__device__ __forceinline__ void out_prefetch(KP p, int cidx, int tid, OutPre& R) {
    const int n = cidx & 127, bh = cidx >> 7, h = bh & 3, b = bh >> 2, tok0 = b * SEQ + n * 128;
    const int lane = tid & 63, w = __builtin_amdgcn_readfirstlane(tid >> 6);
    const bf16_t* proj = (const bf16_t*)(p->ws + WS_PROJ);
    const int lr = tid >> 2, cb = (tid & 3) * 32, tok = tok0 + lr, spos = n * 128 + lr;
    const bf16_t* cs = (const bf16_t*)(p->ws + WS_DC) + (size_t)cidx * 16384;
#pragma unroll
    for (int i = 0; i < 4; ++i) { const int q = tid + i * 512, row = q >> 4, ch = q & 15; R.rc[i] = *(const u32x4*)(cs + row * 128 + ch * 8); }
    conv_rows_load(proj, tok, spos, 1536 + h * 128 + cb, R.rq);
    conv_rows_load(proj, tok, spos, 2048 + h * 128 + cb, R.rk);
    { const bf16_t* vs = proj + (size_t)tok * PROJ_LD + 2560 + h * 128 + cb; R.rv[0] = *(const u32x4*)vs; R.rv[1] = *(const u32x4*)(vs + 8); }
    R.m0 = ((const float*)(p->ws + WS_CHM0))[cidx];
    if (w == 0) {
        const float* gates = (const float*)(p->ws + WS_GATES);
        const int l0 = 2 * lane;
        R.ig0 = gates[(size_t)(tok0 + l0) * 8 + h]; R.lf0 = gates[(size_t)(tok0 + l0) * 8 + 4 + h];
        R.ig1 = gates[(size_t)(tok0 + l0 + 1) * 8 + h]; R.lf1 = gates[(size_t)(tok0 + l0 + 1) * 8 + 4 + h];
    }
    if (tid >= 128 && tid < 256) R.n0v = ((const float*)(p->ws + WS_DN))[(size_t)cidx * 128 + tid - 128];
}
__device__ __forceinline__ void mlstm_out_task(ldsp lds, KP p, int l, int cidx, OutPre& R, int next_cidx, bool dry = false) {
    const int n = cidx & 127, bh = cidx >> 7, h = bh & 3, b = bh >> 2, tok0 = b * SEQ + n * 128;
    const int tid = otid(), lane = tid & 63, w = __builtin_amdgcn_readfirstlane(tid >> 6), fr = lane & 15, fq = lane >> 4;
    ldsp Q = lds, KP = lds + 32768, VT = lds + 65536, CT = lds + 98304;
    PG8_LAS float* gA = (PG8_LAS float*)(lds + 131072); PG8_LAS float* MA = gA + 128; PG8_LAS float* bA = gA + 256; PG8_LAS float* dq = gA + 384; PG8_LAS float* n0s = gA + 512;
    bf16_t* proj = (bf16_t*)(p->ws + WS_PROJ);
    const float m0 = R.m0;
    if (w == 0) {
        const int l0 = 2 * lane;
        const float ig0 = R.ig0, lf0 = R.lf0, ig1 = R.ig1, lf1 = R.lf1;
        const float incl = wave_incl_sum(lf0 + lf1, lane);
        const float b1 = incl, b0 = incl - lf1;
        const float g0 = ig0 - b0, g1 = ig1 - b1;
        const float pm = wave_incl_max(fmaxf(g0, g1), lane);
        float ex = shup(pm, 1, lane); if (lane == 0) ex = -INFINITY;
        const float pm0 = fmaxf(ex, g0), pm1 = pm;
        gA[l0] = g0; gA[l0 + 1] = g1; bA[l0] = b0; bA[l0 + 1] = b1;
        MA[l0] = fmaxf(pm0, m0); MA[l0 + 1] = fmaxf(pm1, m0);
    }
    if (tid >= 128 && tid < 256) n0s[tid - 128] = R.n0v;
    PG8_LAS float* wts = (PG8_LAS float*)(lds + 131072 + 2560);
    conv_table_fill(wts, p->in[8] + (size_t)l * 4096, p->in[9] + l * 1024, h, tid);
    if (tid >= 320 && tid < 352) *(PG8_LAS f32x4*)(wts + 1280 + (tid - 320) * 4) = *(const f32x4*)(p->in[12] + l * 512 + h * 128 + (tid - 320) * 4);
    {
        const int lr = tid >> 2, cb = (tid & 3) * 32, tok = tok0 + lr, spos = n * 128 + lr;
        __syncthreads();
#pragma unroll
        for (int hf = 0; hf < 2; ++hf) {
            const int c0 = cb + hf * 16;
            float o[16];
            conv16_regs(R.rq, spos, wts, c0, o);
            u32x4 w0, w1;
            w0.x = cvt_pk_bf16(o[0], o[1]); w0.y = cvt_pk_bf16(o[2], o[3]); w0.z = cvt_pk_bf16(o[4], o[5]); w0.w = cvt_pk_bf16(o[6], o[7]);
            w1.x = cvt_pk_bf16(o[8], o[9]); w1.y = cvt_pk_bf16(o[10], o[11]); w1.z = cvt_pk_bf16(o[12], o[13]); w1.w = cvt_pk_bf16(o[14], o[15]);
            *(PG8_LAS u32x4*)(Q + swz(lr, c0 >> 3)) = w0; *(PG8_LAS u32x4*)(Q + swz(lr, (c0 >> 3) + 1)) = w1;
            conv16_regs(R.rk, spos, wts, 128 + c0, o);
            const float ks = 0.08838834764831845f;
            w0.x = cvt_pk_bf16(o[0] * ks, o[1] * ks); w0.y = cvt_pk_bf16(o[2] * ks, o[3] * ks); w0.z = cvt_pk_bf16(o[4] * ks, o[5] * ks); w0.w = cvt_pk_bf16(o[6] * ks, o[7] * ks);
            w1.x = cvt_pk_bf16(o[8] * ks, o[9] * ks); w1.y = cvt_pk_bf16(o[10] * ks, o[11] * ks); w1.z = cvt_pk_bf16(o[12] * ks, o[13] * ks); w1.w = cvt_pk_bf16(o[14] * ks, o[15] * ks);
            *(PG8_LAS u32x4*)(KP + swz(lr, c0 >> 3)) = w0; *(PG8_LAS u32x4*)(KP + swz(lr, (c0 >> 3) + 1)) = w1;
            const unsigned rw[8] = {R.rv[0].x, R.rv[0].y, R.rv[0].z, R.rv[0].w, R.rv[1].x, R.rv[1].y, R.rv[1].z, R.rv[1].w};
#pragma unroll
            for (int j = 0; j < 16; ++j) { const int e = c0 + j; const unsigned v16 = (j & 1) ? (rw[j >> 1] >> 16) : (rw[j >> 1] & 0xffffu);
                *(PG8_LAS bf16_t*)(VT + e * 256 + (((lr >> 3) ^ (e & 15)) << 4) + (lr & 7) * 2) = (bf16_t)v16; }
            if (hf == 0) {
                conv_rows_load(proj, tok, spos, 1536 + h * 128 + cb + 16, R.rq);
                conv_rows_load(proj, tok, spos, 2048 + h * 128 + cb + 16, R.rk);
                const bf16_t* vs = proj + (size_t)tok * PROJ_LD + 2560 + h * 128 + cb + 16; R.rv[0] = *(const u32x4*)vs; R.rv[1] = *(const u32x4*)(vs + 8);
            }
        }
#pragma unroll
        for (int i = 0; i < 4; ++i) { const int q = tid + i * 512, row = q >> 4, ch = q & 15; *(PG8_LAS u32x4*)(CT + swz(row, ch)) = R.rc[i]; }
    }
    __syncthreads();
    if (next_cidx >= 0) out_prefetch(p, next_cidx, tid, R);
    {
        const int t = tid >> 2, part = tid & 3; float s = 0.f;
#pragma unroll
        for (int i = 0; i < 4; ++i) {
            const int ch = part * 4 + i;
            const u32x4 v = *(const PG8_LAS u32x4*)(Q + swz(t, ch));
            const PG8_LAS float* nn = n0s + ch * 8;
            s += bflo(v.x) * nn[0] + bfhi(v.x) * nn[1] + bflo(v.y) * nn[2] + bfhi(v.y) * nn[3] + bflo(v.z) * nn[4] + bfhi(v.z) * nn[5] + bflo(v.w) * nn[6] + bfhi(v.w) * nn[7];
        }
        s += shx(s, 1, lane); s += shx(s, 2, lane);
        if (part == 0) dq[t] = s;
    }
    const int t = 16 * w + fr;
    const float Mt = MA[t];
    bf16_t* orow = proj + (size_t)(tok0 + t) * PROJ_LD + 512 + h * 128 + fq * 4;
    u32x2 ovp[8];
#pragma unroll
    for (int nt = 0; nt < 8; ++nt) ovp[nt] = *(const u32x2*)(orow + nt * 16);
    f32x4 acc[8];
#pragma unroll
    for (int i = 0; i < 8; ++i) acc[i] = (f32x4){0.f, 0.f, 0.f, 0.f};
    strip_mma<8>(Q, 16 * w, KP, acc, lane, 0, 4, w + 1);
    float rowsum = 0.f;
    u32x2 pk[8];
#pragma unroll
    for (int nt = 0; nt < 8; ++nt) {
        float pv[4];
#pragma unroll
        for (int j = 0; j < 4; ++j) {
            const int s = nt * 16 + fq * 4 + j;
            const float wgt = (s <= t) ? __expf(gA[s] - Mt) : 0.f;
            pv[j] = (nt <= w) ? acc[nt][j] * wgt : 0.f;
            rowsum += pv[j];
        }
        pk[nt].x = cvt_pk_bf16(pv[0], pv[1]); pk[nt].y = cvt_pk_bf16(pv[2], pv[3]);
    }
    __syncthreads();
#pragma unroll
    for (int nt = 0; nt < 8; ++nt) *(PG8_LAS u32x2*)(KP + swz(t, nt * 2 + (fq >> 1)) + (fq & 1) * 8) = pk[nt];
    f32x4 acc2[8];
#pragma unroll
    for (int i = 0; i < 8; ++i) acc2[i] = (f32x4){0.f, 0.f, 0.f, 0.f};
    strip_mma<8>(Q, 16 * w, CT, acc2, lane, 0, 4, 8);
    const float iw = __expf(m0 - Mt);
#pragma unroll
    for (int i = 0; i < 8; ++i) acc2[i] = acc2[i] * iw;
    asm volatile("s_waitcnt lgkmcnt(0)" ::: "memory");
    strip_mma<8>(KP, 16 * w, VT, acc2, lane, 0, (16 * w + 15) / 32 + 1, 8);
    rowsum += shx(rowsum, 16, lane); rowsum += shx(rowsum, 32, lane);
    const float den = iw * dq[t] + rowsum;
    const float inv = 1.0f / fmaxf(fabsf(den), __expf(-(bA[t] + Mt)));
    float ss = 0.f;
#pragma unroll
    for (int nt = 0; nt < 8; ++nt) {
        const u32x2 ov = ovp[nt];
        acc2[nt][0] = acc2[nt][0] * inv * sigmoid_f(bflo(ov.x)); acc2[nt][1] = acc2[nt][1] * inv * sigmoid_f(bfhi(ov.x));
        acc2[nt][2] = acc2[nt][2] * inv * sigmoid_f(bflo(ov.y)); acc2[nt][3] = acc2[nt][3] * inv * sigmoid_f(bfhi(ov.y));
        ss += sum4(acc2[nt] * acc2[nt]);
    }
    ss += shx(ss, 16, lane); ss += shx(ss, 32, lane);
    const float rn = rsqrtf(ss * (1.0f / 128.0f) + EPS);
    const PG8_LAS float* ng = wts + 1280 + fq * 4;
#pragma unroll
    for (int nt = 0; nt < 8; ++nt) {
        const f32x4 gv = *(const PG8_LAS f32x4*)(ng + nt * 16);
        u32x2 o; o.x = cvt_pk_bf16(acc2[nt][0] * rn * gv[0], acc2[nt][1] * rn * gv[1]); o.y = cvt_pk_bf16(acc2[nt][2] * rn * gv[2], acc2[nt][3] * rn * gv[3]);
        if (!dry) *(u32x2*)(orow + nt * 16) = o;
    }
    __syncthreads();
}

__device__ __forceinline__ void mlstm_out_all(ldsp lds, KP p, int l, bool dry = false) {
    const int G = (int)gridDim.x; int t = obid();
    if (t >= 1024) return;
    OutPre R;
    R.ig0 = R.lf0 = R.ig1 = R.lf1 = R.n0v = 0.f;
    out_prefetch(p, t, otid(), R);
    for (; t < 1024; t += G) mlstm_out_task(lds, p, l, t, R, t + G < 1024 ? t + G : -1, dry);
}

__device__ __forceinline__ void actfix_phase(KP p, int l) {
    const float* __restrict__ halo = (const float*)(p->ws + WS_HALO); bf16_t* __restrict__ act = (bf16_t*)(p->ws + WS_ACT);
    const float* cw = p->in[16] + (size_t)l * 3 * UPN; const float* cb = p->in[17] + (size_t)l * UPN;
    const int nitems = 512 * 2 * (DFF / 4);
    for (int it = obid() * 512 + otid(); it < nitems; it += gridDim.x * 512) {
        const int g = it % (DFF / 4), br = it / (DFF / 4), rr = br & 1, blk = br >> 1, ch = g * 4;
        const bool seqstart = (blk & 255) == 0;
        const f32x4 z = (f32x4){0.f, 0.f, 0.f, 0.f};
        const float* cur = halo + (size_t)(blk * 4 + rr) * UPN + ch;
        const float* pt = halo + (size_t)((blk - 1) * 4 + 2) * UPN + ch;
        const f32x4 xa = *(const f32x4*)cur, xb = *(const f32x4*)(cur + DFF);
        f32x4 p1a, p1b, p2a, p2b;
        if (rr == 0) {
            p1a = seqstart ? z : *(const f32x4*)(pt + UPN); p1b = seqstart ? z : *(const f32x4*)(pt + UPN + DFF);
            p2a = seqstart ? z : *(const f32x4*)pt;         p2b = seqstart ? z : *(const f32x4*)(pt + DFF);
        } else {
            p1a = *(const f32x4*)(cur - UPN); p1b = *(const f32x4*)(cur - UPN + DFF);
            p2a = seqstart ? z : *(const f32x4*)(pt + UPN); p2b = seqstart ? z : *(const f32x4*)(pt + UPN + DFF);
        }
        const f32x4 wa0 = *(const f32x4*)(cw + ch), wa1 = *(const f32x4*)(cw + UPN + ch), wa2 = *(const f32x4*)(cw + 2 * UPN + ch), ba = *(const f32x4*)(cb + ch);
        const f32x4 wb0 = *(const f32x4*)(cw + DFF + ch), wb1 = *(const f32x4*)(cw + UPN + DFF + ch), wb2 = *(const f32x4*)(cw + 2 * UPN + DFF + ch), bb = *(const f32x4*)(cb + DFF + ch);
        const f32x4 ca = ba + wa0 * p2a + wa1 * p1a + wa2 * xa, cbv = bb + wb0 * p2b + wb1 * p1b + wb2 * xb;
        u32x2 o; o.x = cvt_pk_bf16(silu_f(ca[0]) * cbv[0], silu_f(ca[1]) * cbv[1]); o.y = cvt_pk_bf16(silu_f(ca[2]) * cbv[2], silu_f(ca[3]) * cbv[3]);
        *(u32x2*)(act + (size_t)(blk * 64 + rr) * DFF + ch) = o;
    }
}

__device__ __forceinline__ void pconv_phase(KP p, int l) {
    const float* __restrict__ src = p->in[1] + (size_t)l * NTOK * 256; bf16_t* __restrict__ dst = (bf16_t*)(p->ws + WS_PBF);
    const int nitems = NTOK * 256 / 8, stride = gridDim.x * 512;
    for (int i0 = obid() * 512 + otid(); i0 < nitems; i0 += stride * 4) {
        f32x4 a[4], b[4];
#pragma unroll
        for (int u = 0; u < 4; ++u) { const int i = i0 + u * stride < nitems ? i0 + u * stride : i0; a[u] = *(const f32x4*)(src + (size_t)i * 8); b[u] = *(const f32x4*)(src + (size_t)i * 8 + 4); }
#pragma unroll
        for (int u = 0; u < 4; ++u) { const int i = i0 + u * stride;
            if (i < nitems) { u32x4 wv; wv.x = cvt_pk_bf16(a[u][0], a[u][1]); wv.y = cvt_pk_bf16(a[u][2], a[u][3]); wv.z = cvt_pk_bf16(b[u][0], b[u][1]); wv.w = cvt_pk_bf16(b[u][2], b[u][3]); *(u32x4*)(dst + (size_t)i * 8) = wv; } }
    }
}

__device__ __forceinline__ void final_phase(KP p, const float* ssq) {
    const int tid = otid(), lane = tid & 63, w = __builtin_amdgcn_readfirstlane(tid >> 6);
    f32x4 g[4];
#pragma unroll
    for (int i = 0; i < 4; ++i) g[i] = *(const f32x4*)(p->in[22] + i * 256 + lane * 4);
    for (int rowb = obid() * 8 + w; rowb < NTOK; rowb += gridDim.x * 8 * 4) {
        const int rstep = gridDim.x * 8;
        f32x4 xv[4][4]; float rr[4];
#pragma unroll
        for (int u = 0; u < 4; ++u) { const int row = rowb + u * rstep < NTOK ? rowb + u * rstep : rowb; rr[u] = rowscale(ssq, row);
#pragma unroll
            for (int i = 0; i < 4; ++i) xv[u][i] = *(const f32x4*)(p->out + (size_t)row * DM + i * 256 + lane * 4); }
#pragma unroll
        for (int u = 0; u < 4; ++u) { const int row = rowb + u * rstep;
            if (row < NTOK) {
#pragma unroll
                for (int i = 0; i < 4; ++i) *(f32x4*)(p->out + (size_t)row * DM + i * 256 + lane * 4) = xv[u][i] * rr[u] * g[i];
            } }
    }
}

#ifndef PROBE_STAGE
#define PROBE_STAGE 0
#endif
__device__ __forceinline__ void dump_phase(KP p) {
    const bf16_t* proj = (const bf16_t*)(p->ws + WS_PROJ); const float* gates = (const float*)(p->ws + WS_GATES); const float* lnstat = (const float*)(p->ws + WS_LNSTAT);
    const bf16_t* dc = (const bf16_t*)(p->ws + WS_DC); const float* dn = (const float*)(p->ws + WS_DN); const float* chs = (const float*)(p->ws + WS_CHBL);
    for (int i = obid() * 512 + otid(); i < NTOK * DM; i += gridDim.x * 512) {
        const int row = i >> 10, c = i & 1023;
        float v = bf2f(proj[(size_t)row * PROJ_LD + c]) + bf2f(proj[(size_t)row * PROJ_LD + 1024 + c]) + bf2f(proj[(size_t)row * PROJ_LD + 2048 + c]) + gates[(size_t)row * 8 + (c & 7)] + lnstat[(size_t)row * 16 + (c & 15)];
        if (PROBE_STAGE >= 2) v += bf2f(dc[i & (8 * 128 * 16384 - 1)]) + dn[i & 131071] + chs[i & 2047];
        if (PROBE_STAGE >= 3) v += chs[2048 + (i & 1023)];
        p->out[i] = v;
    }
}
#define PROBE_AT(s) do { if (PROBE_STAGE == (s)) { if ((s) <= 4) dump_phase(p); return; } } while (0)
#define XB_TMO      128
#define XB_XCNT(j)  (256  + 64 * (j))
#define XB_XSUB(j)  (1280 + 64 * (j))
#define XB_XGEN(j)  (2304 + 64 * (j))
#define XB_TOP      3328
#define XB_TOPGEN   3392
#define XCD_BAR_WORDS 3456
#define XB_SPIN_CAP (1u << 18)

__device__ __forceinline__ unsigned xb_ld(unsigned* p)              { return __hip_atomic_load(p, __ATOMIC_RELAXED, __HIP_MEMORY_SCOPE_AGENT); }
__device__ __forceinline__ unsigned xb_add(unsigned* p, unsigned v) { return __hip_atomic_fetch_add(p, v, __ATOMIC_RELAXED, __HIP_MEMORY_SCOPE_AGENT); }
__device__ __forceinline__ unsigned xb_xcc_id() { return (unsigned)__builtin_amdgcn_s_getreg((3 << 11) | 20) & 0xFu; }
#define XB_SPIN(cond, bar) do { unsigned _sp = 0; while (cond) { __builtin_amdgcn_s_sleep(1); \
    if ((++_sp & 255u) == 0u) { if (xb_ld(&(bar)[XB_TMO])) break; if (_sp > XB_SPIN_CAP) { atomicAdd(&(bar)[XB_TMO], 1u); break; } } } } while (0)

struct XcdBarrier {
    unsigned* bar; unsigned x;
    volatile PG8_LAS unsigned* st;
};

__device__ __forceinline__ XcdBarrier xcd_barrier_post(unsigned* bar, volatile PG8_LAS unsigned* st) {
    XcdBarrier b; b.bar = bar; b.x = xb_xcc_id(); b.st = st;
    if (otid() == 0) (void)xb_add(&bar[XB_XCNT(b.x)], 1u);
    return b;
}
__device__ __forceinline__ void xcd_barrier_complete(unsigned* bar, unsigned x, unsigned& nloc, unsigned& nx) {
    const unsigned G = gridDim.x * gridDim.y * gridDim.z;
    unsigned sum, cnt, mine, sp = 0u;
    for (;;) {
        sum = 0u; cnt = 0u; mine = 0u;
#pragma unroll
        for (unsigned j = 0; j < 16; ++j) { const unsigned c = xb_ld(&bar[XB_XCNT(j)]); sum += c; cnt += (c > 0u) ? 1u : 0u; mine = (j == x) ? c : mine; }
        if (sum == G) break;
        __builtin_amdgcn_s_sleep(1);
        if ((++sp & 255u) == 0u) { if (xb_ld(&bar[XB_TMO])) break; if (sp > XB_SPIN_CAP) { atomicAdd(&bar[XB_TMO], 1u); break; } }
    }
    nloc = mine > 0u ? mine : 1u; nx = cnt > 0u ? cnt : 1u;
}

__device__ __forceinline__ void xcd_barrier(const XcdBarrier& b) {
    asm volatile("s_waitcnt vmcnt(0)" ::: "memory");
    __syncthreads();
    if (otid() == 0) {
        unsigned* bar = b.bar;
        __builtin_amdgcn_s_waitcnt(0);
        unsigned nloc = b.st[0], nx = b.st[1];
        if (nloc == 0u) { xcd_barrier_complete(bar, b.x, nloc, nx); b.st[0] = nloc; b.st[1] = nx; }
        const unsigned old = xb_add(&bar[XB_XSUB(b.x)], 1u);
        const unsigned gen = old / nloc;
        if (old + 1u == (gen + 1u) * nloc) {
            __builtin_amdgcn_fence(__ATOMIC_RELEASE, "agent");
            asm volatile("s_waitcnt vmcnt(0)" ::: "memory");
            const unsigned og = xb_add(&bar[XB_TOP], 1u);
            const unsigned tg = og / nx;
            if (og + 1u == (tg + 1u) * nx) xb_add(&bar[XB_TOPGEN], 1u);
            else XB_SPIN(xb_ld(&bar[XB_TOPGEN]) == tg, bar);
            __builtin_amdgcn_fence(__ATOMIC_ACQUIRE, "agent");
            xb_add(&bar[XB_XGEN(b.x)], 1u);
            asm volatile("s_waitcnt vmcnt(0)" ::: "memory");
        } else {
            XB_SPIN(xb_ld(&bar[XB_XGEN(b.x)]) == gen, bar);
            __builtin_amdgcn_fence(__ATOMIC_ACQUIRE, "agent");
            asm volatile("s_waitcnt vmcnt(0)" ::: "memory");
        }
    }
    __syncthreads();
}


#define GSYNC() do { asm volatile("s_waitcnt vmcnt(0)" ::: "memory"); grid.sync(); } while (0)
#define XSYNC() do { XcdBarrier t_; t_.bar = (unsigned*)(p->ws + WS_BAR); t_.x = xb_x; t_.st = xst; asm volatile("" : "+s"(t_.x)); xcd_barrier(t_); } while (0)
__global__ void __launch_bounds__(512, 2) fwd_kernel(Params p_arg) {
    KP kp0 = (KP)__builtin_amdgcn_kernarg_segment_ptr(); (void)p_arg;
#define p okp(kp0)
    extern __shared__ __attribute__((aligned(16))) unsigned char shm[];
    ldsp lds = (ldsp)shm;
    cg::grid_group grid = cg::this_grid();
    unsigned char* ws = p->ws;
    volatile PG8_LAS unsigned* xst = (volatile PG8_LAS unsigned*)(lds + 131072 + 1024 + 8192);
    if (threadIdx.x < 4) xst[threadIdx.x] = 0u;
    __syncthreads();
    const unsigned xb_x = __builtin_amdgcn_readfirstlane(xcd_barrier_post((unsigned*)(ws + WS_BAR), xst).x);
    prep_phase(lds, p);
#ifdef REP_PREP
    prep_phase(lds, p);
#endif
    if (p->ws == nullptr) GSYNC();
    XSYNC();
    int cur = 0;
#pragma unroll 1
    for (int l = 0; l < DEPTH; ++l) {
        bf16_t* xb_c = (bf16_t*)(ws + (cur ? WS_XB1 : WS_XB0)); bf16_t* xb_n = (bf16_t*)(ws + (cur ? WS_XB0 : WS_XB1));
        float* ssq_c = (float*)(ws + (cur ? WS_SSQ1 : WS_SSQ0)); float* ssq_n = (float*)(ws + (cur ? WS_SSQ0 : WS_SSQ1));
        const unsigned char* wt = ws + WS_WT + (size_t)l * WT_LAYER;
        bf16_t* proj = (bf16_t*)(ws + WS_PROJ);
#ifdef REP_A
        gates_phase(lds, p, l, xb_c, ssq_c, 2);
        { EpiProj E; E.rl = (PG8_LAS float*)(lds + 131072); E.proj = proj; E.ssq = ssq_c; E.lnstat = (float*)(ws + WS_LNSTAT); run_gemm(lds, xb_c, DM, (const bf16_t*)(wt + WT_IN), NTOK, 3072, 1024, E); }
#endif
        if (obid() & 1) gates_phase(lds, p, l, xb_c, ssq_c, 2);
        { EpiProj E; E.rl = (PG8_LAS float*)(lds + 131072); E.proj = proj; E.ssq = ssq_c; E.lnstat = (float*)(ws + WS_LNSTAT); run_gemm(lds, xb_c, DM, (const bf16_t*)(wt + WT_IN), NTOK, 3072, 1024, E); }
        if (!(obid() & 1)) gates_phase(lds, p, l, xb_c, ssq_c, 2);
        XSYNC();
        PROBE_AT(1);
#ifdef REP_GM
        for (int t = obid(); t < 2048; t += gridDim.x) gmlp_task(lds, p, l, t, true);
#endif
#ifdef REP_DC
        mlstm_dc_all(lds, p, l);
#endif
#ifdef REP_SYNC
        for (int q = 0; q < 10; ++q) XSYNC();
#endif
        mlstm_dc_all(lds, p, l);
        for (int t = obid(); t < 3072; t += gridDim.x) {

#if !defined(PROBE_B_ONLY) || PROBE_B_ONLY == 2
            if (t >= 1024) gmlp_task(lds, p, l, t - 1024);
#endif
        }
        XSYNC();
        PROBE_AT(2);
#ifdef REP_C
        scan_phase(p, true);
#endif
        scan_phase(p);
        XSYNC();
        PROBE_AT(3);
#ifdef REP_D
        mlstm_out_all(lds, p, l, true);
#endif
        mlstm_out_all(lds, p, l);
        XSYNC();
        PROBE_AT(4);
#ifdef REP_E0
        if (l == 0) { EpiResid E; E.dry = 0; E.xin = p->in[0]; E.xout = p->out; E.xb = xb_n; E.ssq = ssq_n; E.row_off = 0; run_gemm(lds, proj, PROJ_LD, (const bf16_t*)(wt + WT_OUT), NTOK, 1024, 1024, E); }
#endif
        { EpiResid E; E.dry = 0; E.xin = l == 0 ? p->in[0] : p->out; E.xout = p->out; E.xb = xb_n; E.ssq = ssq_n; E.row_off = 0; run_gemm(lds, proj, PROJ_LD, (const bf16_t*)(wt + WT_OUT), NTOK, 1024, 1024, E); }
        XSYNC();
        PROBE_AT(5);
        { EpiUpAct E; E.rl = (PG8_LAS float*)(lds + 131072); E.act = (bf16_t*)(ws + WS_ACT); E.halo = (float*)(ws + WS_HALO); E.ssq = ssq_n; E.cw = p->in[16] + (size_t)l * 3 * UPN; E.cb = p->in[17] + (size_t)l * UPN;
          run_gemm(lds, xb_n, DM, (const bf16_t*)(wt + WT_UP), NTOK, UPN, 1024, E);
#ifdef REP_F
          run_gemm(lds, xb_n, DM, (const bf16_t*)(wt + WT_UP), NTOK, UPN, 1024, E);
#endif
        }
        XSYNC();
#ifdef REP_G
        actfix_phase(p, l);
#endif
        actfix_phase(p, l);
        XSYNC();
#ifdef REP_PCONV
        pconv_phase(p, l);
#endif
#ifdef REP_H
        { EpiResid E; E.dry = 1; E.xin = p->out; E.xout = p->out; E.xb = xb_c; E.ssq = ssq_c; E.row_off = 0; run_gemm(lds, (const bf16_t*)(ws + WS_ACT), DFF, (const bf16_t*)(wt + WT_DOWN), NTOK, 1024, DFF, E); }
#endif
        if (obid() & 1) pconv_phase(p, l);
        { EpiResid E; E.dry = 0; E.xin = p->out; E.xout = p->out; E.xb = xb_c; E.ssq = ssq_c; E.row_off = 0; run_gemm(lds, (const bf16_t*)(ws + WS_ACT), DFF, (const bf16_t*)(wt + WT_DOWN), NTOK, 1024, DFF, E); }
        if (!(obid() & 1)) pconv_phase(p, l);
        XSYNC();
        PROBE_AT(6);
#ifdef REP_PE
        { EpiPe E; E.pe = (bf16_t*)(ws + WS_PE); run_gemm(lds, (const bf16_t*)(ws + WS_PBF), 256, (const bf16_t*)(wt + WT_PLE), NTOK, 1024, 256, E); }
#endif
        { EpiPe E; E.pe = (bf16_t*)(ws + WS_PE); run_gemm(lds, (const bf16_t*)(ws + WS_PBF), 256, (const bf16_t*)(wt + WT_PLE), NTOK, 1024, 256, E); }
#ifdef REP_GATE
        { EpiGate E; E.dry = 1; E.rl = (PG8_LAS float*)(lds + 131072); E.x = p->out; E.pe = (const bf16_t*)(ws + WS_PE); E.ssq_in = ssq_c; E.xb = xb_n; E.ssq = ssq_n; run_gemm(lds, xb_c, DM, (const bf16_t*)(wt + WT_GATE), NTOK, 1024, 1024, E); }
#endif
        { EpiGate E; E.dry = 0; E.rl = (PG8_LAS float*)(lds + 131072); E.x = p->out; E.pe = (const bf16_t*)(ws + WS_PE); E.ssq_in = ssq_c; E.xb = xb_n; E.ssq = ssq_n; run_gemm(lds, xb_c, DM, (const bf16_t*)(wt + WT_GATE), NTOK, 1024, 1024, E); }
        XSYNC();
        PROBE_AT(7);
        cur ^= 1;
    }
    final_phase(p, (const float*)(ws + (cur ? WS_SSQ1 : WS_SSQ0)));
}

#undef p
extern "C" void kernel_launch(void* const* d_in, const int* in_sizes, int n_in, void* d_out, int out_size, void* d_ws, size_t ws_size, hipStream_t stream) {
    static int grid_blocks = 0;
    if (grid_blocks == 0) {
        if (n_in != 23 || ws_size < WS_END) { fprintf(stderr, "kernel_launch: unexpected n_in %d / ws_size %zu (need %zu)\n", n_in, ws_size, (size_t)WS_END); grid_blocks = -1; return; }
        int dev = 0, cus = 0, per_cu = 0;
        hipGetDevice(&dev);
        hipDeviceGetAttribute(&cus, hipDeviceAttributeMultiprocessorCount, dev);
        if (hipFuncSetAttribute((const void*)fwd_kernel, hipFuncAttributeMaxDynamicSharedMemorySize, LDS_BYTES) != hipSuccess) { fprintf(stderr, "kernel_launch: hipFuncSetAttribute failed\n"); grid_blocks = -1; return; }
        if (hipOccupancyMaxActiveBlocksPerMultiprocessor(&per_cu, (const void*)fwd_kernel, 512, LDS_BYTES) != hipSuccess || per_cu < 1) { fprintf(stderr, "kernel_launch: occupancy query failed (%d)\n", per_cu); per_cu = 1; (void)hipGetLastError(); }
        grid_blocks = cus * per_cu;
        if (grid_blocks > 256) grid_blocks = 256;
    }
    if (grid_blocks < 0) return;
    if (hipMemsetAsync((char*)d_ws + WS_BAR, 0, XCD_BAR_WORDS * sizeof(unsigned), stream) != hipSuccess) { fprintf(stderr, "kernel_launch: memset of the barrier words failed\n"); return; }
    Params p{};
    for (int i = 0; i < 23; ++i) p.in[i] = (const float*)d_in[i];
    p.out = (float*)d_out; p.ws = (unsigned char*)d_ws;
    void* args[] = {&p};
    hipError_t e = hipLaunchCooperativeKernel((const void*)fwd_kernel, dim3(grid_blocks), dim3(512), args, LDS_BYTES, stream);
    if (e != hipSuccess) fprintf(stderr, "cooperative launch failed: %s (grid %d)\n", hipGetErrorString(e), grid_blocks);
}
```
